# Optimizing an MI355X kernel written in HIP

```python
import jax
import jax.numpy as jnp
from jax import lax
import numpy as np


D_MODEL = 1024
BATCH = 8
SEQ = 4096
DEPTH = 1

LRU_WIDTH = D_MODEL // 2
LRU_BLOCKS = 8
LRU_BLOCK = LRU_WIDTH // LRU_BLOCKS
CONV_WIDTH = 4
LRU_C = 8.0
NSA_HEADS = 8
HEAD_DIM = 64
NSA_WIDTH = NSA_HEADS * HEAD_DIM
NSA_KV_HEADS = 2
NSA_GROUP = NSA_HEADS // NSA_KV_HEADS
KV_WIDTH = NSA_KV_HEADS * HEAD_DIM
N_BRANCH = 3
CMP_STRIDE = 16
CMP_BLOCK = 2 * CMP_STRIDE
CMP_HIDDEN = 256
SEL_BLOCK = 64
SEL_TOPK = 16
WINDOW = 512
Q_BLOCK = 128
SEL_Q_CHUNK = 16
MIX_WIDTH = LRU_WIDTH + NSA_WIDTH
IN_SPLITS = (LRU_WIDTH, LRU_WIDTH, NSA_WIDTH, KV_WIDTH, KV_WIDTH, KV_WIDTH, KV_WIDTH, KV_WIDTH, KV_WIDTH, N_BRANCH * NSA_HEADS, NSA_WIDTH)
IN_WIDTH = sum(IN_SPLITS)
ATTN_SCALE = HEAD_DIM ** -0.5
NEG_INF = -1e30
FORCE = 1e6
EPS = 1e-6

kernel_name = 'hymba_rglru_nsa_alibi_adaln_block'


def rms_norm(x, g):
    xf = x.astype(jnp.float32)
    y = xf * lax.rsqrt(jnp.mean(xf * xf, axis=-1, keepdims=True) + EPS)
    return (y * g.astype(jnp.float32)).astype(x.dtype)


def alibi_slopes():
    h = jnp.arange(1, NSA_HEADS + 1, dtype=jnp.float32)
    return (2.0 ** (-8.0 * h / NSA_HEADS)).reshape(NSA_KV_HEADS, NSA_GROUP)


def masked_softmax(s, mask):
    return jax.nn.softmax(jnp.where(mask, s, NEG_INF), axis=-1)


def causal_depthwise_conv(x, w, b):
    y = lax.conv_general_dilated(x, w[:, None, :].astype(x.dtype), window_strides=(1,), padding=[(CONV_WIDTH - 1, 0)], dimension_numbers=('NWC', 'WIO', 'NWC'), feature_group_count=x.shape[-1])
    return y + b


def rg_lru(xc, w_a, b_a, w_x, b_x, lam):
    bsz, seq, _ = xc.shape
    xb = xc.reshape(bsz, seq, LRU_BLOCKS, LRU_BLOCK)
    r = jax.nn.sigmoid(jnp.einsum('bsni,nij->bsnj', xb, w_a).reshape(bsz, seq, LRU_WIDTH) + b_a)
    i = jax.nn.sigmoid(jnp.einsum('bsni,nij->bsnj', xb, w_x).reshape(bsz, seq, LRU_WIDTH) + b_x)
    log_a = -LRU_C * r.astype(jnp.float32) * jax.nn.softplus(-lam.astype(jnp.float32))
    a = jnp.exp(log_a)
    u = jnp.sqrt(-jnp.expm1(2.0 * log_a)) * (i * xc).astype(jnp.float32)

    def combine(left, right):
        a_l, h_l = left
        a_r, h_r = right
        return a_l * a_r, a_r * h_l + h_r

    _, h = lax.associative_scan(combine, (a, u), axis=1)
    return h.astype(xc.dtype)


def compress_blocks(kv, pos, w1, w2):
    bsz, seq, hk, dh = kv.shape
    chunks = kv.reshape(bsz, seq // CMP_STRIDE, CMP_STRIDE, hk, dh)
    blocks = jnp.concatenate([chunks[:, :-1], chunks[:, 1:]], axis=2) + pos[None, None, :, None, :]
    flat = jnp.moveaxis(blocks, 3, 2).reshape(bsz, seq // CMP_STRIDE - 1, hk, CMP_BLOCK * dh)
    return jax.nn.gelu(flat @ w1) @ w2


def nsa_branches(q, kc, vc, ks, vs, kw, vw, gate_logits):
    bsz, seq = q.shape[:2]
    n_cmp = kc.shape[1]
    n_sel = seq // SEL_BLOCK
    n_top = min(SEL_TOPK, n_sel)
    slopes = alibi_slopes()
    cmp_end = CMP_STRIDE * jnp.arange(n_cmp) + CMP_BLOCK - 1
    cmp_ids = jnp.arange(n_cmp)
    ratio = SEL_BLOCK // CMP_STRIDE
    overlap = jax.nn.one_hot(cmp_ids // ratio, n_sel, dtype=jnp.float32) + jax.nn.one_hot((cmp_ids + 1) // ratio, n_sel, dtype=jnp.float32)
    sel_ids = jnp.arange(n_sel)
    n_qb = seq // Q_BLOCK

    def cmp_step(i):
        t = i * Q_BLOCK + jnp.arange(Q_BLOCK)
        qb = lax.dynamic_slice_in_dim(q, i * Q_BLOCK, Q_BLOCK, axis=1)
        dist = (t[:, None] - cmp_end[None, :]).astype(jnp.float32)
        mask = dist >= 0
        s = jnp.einsum('bqhgd,bchd->bhgqc', qb, kc).astype(jnp.float32) * ATTN_SCALE - slopes[:, :, None, None] * dist
        p = jnp.where(mask, masked_softmax(s, mask), 0.0)
        o = jnp.einsum('bhgqc,bchd->bqhgd', p.astype(vc.dtype), vc)
        imp = jnp.einsum('bhgqc,cn->bqhn', p, overlap)
        cur = (t // SEL_BLOCK)[:, None, None]
        forced = (sel_ids == 0) | (sel_ids == cur) | (sel_ids == cur - 1)
        imp = jnp.where(forced, FORCE, jnp.where(sel_ids > cur, -FORCE, imp))
        _, idx = lax.top_k(imp, n_top)
        return o, idx

    o_cmp, sel_idx = lax.map(cmp_step, jnp.arange(n_qb))
    o_cmp = jnp.moveaxis(o_cmp, 0, 1).reshape(q.shape)
    sel_idx = jnp.moveaxis(sel_idx, 0, 1).reshape(bsz, seq, NSA_KV_HEADS, n_top)

    ks_b = ks.reshape(bsz, n_sel, SEL_BLOCK, NSA_KV_HEADS, HEAD_DIM).transpose(0, 3, 1, 2, 4)
    vs_b = vs.reshape(bsz, n_sel, SEL_BLOCK, NSA_KV_HEADS, HEAD_DIM).transpose(0, 3, 1, 2, 4)
    b_ix = jnp.arange(bsz)[:, None, None, None]
    h_ix = jnp.arange(NSA_KV_HEADS)[None, None, :, None]
    offs = jnp.arange(SEL_BLOCK)
    n_keys = n_top * SEL_BLOCK

    def slc_step(i):
        t = i * SEL_Q_CHUNK + jnp.arange(SEL_Q_CHUNK)
        qb = lax.dynamic_slice_in_dim(q, i * SEL_Q_CHUNK, SEL_Q_CHUNK, axis=1)
        ib = lax.dynamic_slice_in_dim(sel_idx, i * SEL_Q_CHUNK, SEL_Q_CHUNK, axis=1)
        kg = ks_b[b_ix, h_ix, ib]
        vg = vs_b[b_ix, h_ix, ib]
        kpos = ib[..., None] * SEL_BLOCK + offs
        dist = (t[None, :, None, None, None] - kpos).astype(jnp.float32)
        s = jnp.einsum('bqhgd,bqhnkd->bqhgnk', qb, kg).astype(jnp.float32) * ATTN_SCALE - slopes[None, None, :, :, None, None] * dist[:, :, :, None]
        mask = (dist >= 0)[:, :, :, None].reshape(bsz, SEL_Q_CHUNK, NSA_KV_HEADS, 1, n_keys)
        p = masked_softmax(s.reshape(bsz, SEL_Q_CHUNK, NSA_KV_HEADS, NSA_GROUP, n_keys), mask)
        return jnp.einsum('bqhgm,bqhmd->bqhgd', p.astype(vg.dtype), vg.reshape(bsz, SEL_Q_CHUNK, NSA_KV_HEADS, n_keys, HEAD_DIM))

    o_slc = lax.map(slc_step, jnp.arange(seq // SEL_Q_CHUNK))
    o_slc = jnp.moveaxis(o_slc, 0, 1).reshape(q.shape)

    pad = ((0, 0), (WINDOW, 0), (0, 0), (0, 0))
    kw_p = jnp.pad(kw, pad)
    vw_p = jnp.pad(vw, pad)
    span = WINDOW + Q_BLOCK

    def win_step(i):
        t = i * Q_BLOCK + jnp.arange(Q_BLOCK)
        spos = i * Q_BLOCK - WINDOW + jnp.arange(span)
        qb = lax.dynamic_slice_in_dim(q, i * Q_BLOCK, Q_BLOCK, axis=1)
        kb = lax.dynamic_slice_in_dim(kw_p, i * Q_BLOCK, span, axis=1)
        vb = lax.dynamic_slice_in_dim(vw_p, i * Q_BLOCK, span, axis=1)
        dist = (t[:, None] - spos[None, :]).astype(jnp.float32)
        mask = (dist >= 0) & (dist < WINDOW) & (spos[None, :] >= 0)
        s = jnp.einsum('bqhgd,bkhd->bhgqk', qb, kb).astype(jnp.float32) * ATTN_SCALE - slopes[:, :, None, None] * dist
        p = masked_softmax(s, mask)
        return jnp.einsum('bhgqk,bkhd->bqhgd', p.astype(vb.dtype), vb)

    o_win = lax.map(win_step, jnp.arange(n_qb))
    o_win = jnp.moveaxis(o_win, 0, 1).reshape(q.shape)

    g = jax.nn.sigmoid(gate_logits.astype(jnp.float32)).reshape(bsz, seq, N_BRANCH, NSA_KV_HEADS, NSA_GROUP, 1).astype(q.dtype)
    o = g[:, :, 0] * o_cmp + g[:, :, 1] * o_slc + g[:, :, 2] * o_win
    return o.reshape(bsz, seq, NSA_WIDTH)


def hybrid_layer(x, c, w_ada, b_ada, norm_g, w_in, conv_w, conv_b, w_rg_a, b_rg_a, w_rg_x, b_rg_x, lru_lambda, cmp_pos_k, cmp_w1_k, cmp_w2_k, cmp_pos_v, cmp_w1_v, cmp_w2_v, g_q, g_k_cmp, g_k_slc, g_k_win, g_out_lru, g_out_nsa, w_out):
    bsz, seq, _ = x.shape
    mod = jax.nn.silu(c) @ w_ada + b_ada
    shift, scale, gate = jnp.split(mod, 3, axis=-1)
    h = rms_norm(x, norm_g) * (1.0 + scale[:, None, :]) + shift[:, None, :]
    proj = h @ w_in
    offsets = [int(o) for o in np.cumsum(IN_SPLITS)[:-1]]
    x_lru, z_lru, q, k_cmp, v_cmp, k_slc, v_slc, k_win, v_win, gate_logits, z_nsa = jnp.split(proj, offsets, axis=-1)

    h_lru = rg_lru(causal_depthwise_conv(x_lru, conv_w, conv_b), w_rg_a, b_rg_a, w_rg_x, b_rg_x, lru_lambda)
    y_lru = rms_norm(h_lru, g_out_lru) * jax.nn.silu(z_lru)

    kv_shape = (bsz, seq, NSA_KV_HEADS, HEAD_DIM)
    qh = rms_norm(q.reshape(bsz, seq, NSA_KV_HEADS, NSA_GROUP, HEAD_DIM), g_q)
    kc = rms_norm(compress_blocks(k_cmp.reshape(kv_shape), cmp_pos_k, cmp_w1_k, cmp_w2_k), g_k_cmp)
    vc = compress_blocks(v_cmp.reshape(kv_shape), cmp_pos_v, cmp_w1_v, cmp_w2_v)
    ks = rms_norm(k_slc.reshape(kv_shape), g_k_slc)
    kw = rms_norm(k_win.reshape(kv_shape), g_k_win)
    o_nsa = nsa_branches(qh, kc, vc, ks, v_slc.reshape(kv_shape), kw, v_win.reshape(kv_shape), gate_logits)
    y_nsa = rms_norm(o_nsa, g_out_nsa) * jax.nn.silu(z_nsa)

    out = jnp.concatenate([y_lru, y_nsa], axis=-1) @ w_out
    return x + gate[:, None, :] * out


def setup_inputs(seed: int = 0) -> dict:
    key = jax.random.key(seed)
    ks = jax.random.split(key, 26)
    L = DEPTH

    def nrm(k, shape, s):
        return s * jax.random.normal(k, shape, jnp.float32)

    u = jax.random.uniform(ks[12], (L, LRU_WIDTH), jnp.float32, 0.9, 0.999)
    a0 = u ** (1.0 / LRU_C)
    lam = jnp.log(a0) - jnp.log1p(-a0)
    return {
        'x': nrm(ks[0], (BATCH, SEQ, D_MODEL), 1.0),
        'c': nrm(ks[1], (BATCH, D_MODEL), 1.0),
        'w_ada': nrm(ks[2], (L, D_MODEL, 3 * D_MODEL), 0.5 * D_MODEL ** -0.5),
        'b_ada': nrm(ks[3], (L, 3 * D_MODEL), 0.02),
        'norm_g': 1.0 + nrm(ks[4], (L, D_MODEL), 0.02),
        'w_in': nrm(ks[5], (L, D_MODEL, IN_WIDTH), D_MODEL ** -0.5),
        'conv_w': nrm(ks[6], (L, CONV_WIDTH, LRU_WIDTH), CONV_WIDTH ** -0.5),
        'conv_b': nrm(ks[7], (L, LRU_WIDTH), 0.02),
        'w_rg_a': nrm(ks[8], (L, LRU_BLOCKS, LRU_BLOCK, LRU_BLOCK), LRU_BLOCK ** -0.5),
        'b_rg_a': nrm(ks[9], (L, LRU_WIDTH), 0.02),
        'w_rg_x': nrm(ks[10], (L, LRU_BLOCKS, LRU_BLOCK, LRU_BLOCK), LRU_BLOCK ** -0.5),
        'b_rg_x': nrm(ks[11], (L, LRU_WIDTH), 0.02),
        'lru_lambda': lam,
        'cmp_pos_k': nrm(ks[13], (L, CMP_BLOCK, HEAD_DIM), 0.1),
        'cmp_w1_k': nrm(ks[14], (L, CMP_BLOCK * HEAD_DIM, CMP_HIDDEN), (CMP_BLOCK * HEAD_DIM) ** -0.5),
        'cmp_w2_k': nrm(ks[15], (L, CMP_HIDDEN, HEAD_DIM), CMP_HIDDEN ** -0.5),
        'cmp_pos_v': nrm(ks[16], (L, CMP_BLOCK, HEAD_DIM), 0.1),
        'cmp_w1_v': nrm(ks[17], (L, CMP_BLOCK * HEAD_DIM, CMP_HIDDEN), (CMP_BLOCK * HEAD_DIM) ** -0.5),
        'cmp_w2_v': nrm(ks[18], (L, CMP_HIDDEN, HEAD_DIM), CMP_HIDDEN ** -0.5),
        'g_q': 1.0 + nrm(ks[19], (L, HEAD_DIM), 0.02),
        'g_k_cmp': 1.0 + nrm(ks[20], (L, HEAD_DIM), 0.02),
        'g_k_slc': 1.0 + nrm(ks[21], (L, HEAD_DIM), 0.02),
        'g_k_win': 1.0 + nrm(ks[22], (L, HEAD_DIM), 0.02),
        'g_out_lru': 1.0 + nrm(ks[23], (L, LRU_WIDTH), 0.02),
        'g_out_nsa': 1.0 + nrm(ks[24], (L, NSA_WIDTH), 0.02),
        'w_out': nrm(ks[25], (L, MIX_WIDTH, D_MODEL), MIX_WIDTH ** -0.5),
    }


def reference(x, c, w_ada, b_ada, norm_g, w_in, conv_w, conv_b, w_rg_a, b_rg_a, w_rg_x, b_rg_x, lru_lambda, cmp_pos_k, cmp_w1_k, cmp_w2_k, cmp_pos_v, cmp_w1_v, cmp_w2_v, g_q, g_k_cmp, g_k_slc, g_k_win, g_out_lru, g_out_nsa, w_out):
    for layer in range(DEPTH):
        x = hybrid_layer(x, c, w_ada[layer], b_ada[layer], norm_g[layer], w_in[layer], conv_w[layer], conv_b[layer], w_rg_a[layer], b_rg_a[layer], w_rg_x[layer], b_rg_x[layer], lru_lambda[layer], cmp_pos_k[layer], cmp_w1_k[layer], cmp_w2_k[layer], cmp_pos_v[layer], cmp_w1_v[layer], cmp_w2_v[layer], g_q[layer], g_k_cmp[layer], g_k_slc[layer], g_k_win[layer], g_out_lru[layer], g_out_nsa[layer], w_out[layer])
    return x
```

```cpp
#include <hip/hip_runtime.h>
#include <hip/hip_bf16.h>
#include <hip/hip_cooperative_groups.h>
#include <cstdio>
namespace cg = cooperative_groups;

#ifndef FUSED
#define FUSED 1
#endif

typedef __attribute__((ext_vector_type(8))) short bf16x8;
typedef __attribute__((ext_vector_type(4))) float f32x4;
typedef __attribute__((ext_vector_type(16))) float f32x16;
typedef __attribute__((ext_vector_type(4))) unsigned u32x4;
typedef __attribute__((ext_vector_type(2))) unsigned u32x2;
typedef unsigned short u16;
typedef unsigned long long u64;

#ifndef PROBE_PH
#define PROBE_PH 0
#endif
#ifndef LB_MIN
#define LB_MIN 2
#endif
#define NTOK 32768
#define SEQ 4096
#define NP 2944
#define EPSF 1e-6f

struct Params {
  const float *x, *c, *w_ada, *b_ada, *norm_g, *w_in, *conv_w, *conv_b, *w_rg_a, *b_rg_a, *w_rg_x, *b_rg_x, *lam;
  const float *pos_k, *w1_k, *w2_k, *pos_v, *w1_v, *w2_v, *g_q, *g_kc, *g_ks, *g_kw, *g_ol, *g_on, *w_out;
  float* out;
  char* ws;
};
#define OFF_mod 0ull
#define OFF_winT 98304ull
#define OFF_woutT 6127616ull
#define OFF_w1T0 8224768ull
#define OFF_w1T1 9273344ull
#define OFF_w2T0 10321920ull
#define OFF_w2T1 10354688ull
#define OFF_waT 10387456ull
#define OFF_wxT 10452992ull
#define OFF_bias1 10518528ull
#define OFF_H 10520576ull
#define OFF_XZ 77629440ull
#define OFF_Q 144738304ull
#define OFF_KVC 178292736ull
#define OFF_KS 195102720ull
#define OFF_KW 203491328ull
#define OFF_VST 211879936ull
#define OFF_VWT 220268544ull
#define OFF_ZN 228657152ull
#define OFF_GS 262211584ull
#define OFF_CACC 265357312ull
#define OFF_HL 267454464ull
#define OFF_CA 301008896ull
#define OFF_CE 334563328ull
#define OFF_Y OFF_H
#define OFF_KCN (WS_TOTAL + 256ull)
#define OFF_VCT (OFF_KCN + 16ull * 256 * 64 * 2)
#define OFF_CIN (OFF_VCT + 16ull * 64 * 256 * 2)
#define OFF_BAR (OFF_CIN + 8ull * 64 * 512 * 4)
#define OFF_B1S (OFF_BAR + 16384ull + 98304ull)
#define OFF_MODZ (OFF_BAR + 16384ull)
#define WS_TOTAL 336660480ull

typedef __attribute__((ext_vector_type(2))) __bf16 bf2_t;
typedef __attribute__((ext_vector_type(2))) float f2_t;
__device__ __forceinline__ unsigned pack2(float a, float b) {
  f2_t v = {a, b};
  bf2_t r = __builtin_convertvector(v, bf2_t);
  return *(unsigned*)&r;
}
__device__ __forceinline__ u16 f2bf(float f) { return (u16)(pack2(f, 0.f) & 0xffffu); }
__device__ __forceinline__ float dpp_xor1(float v) { return __int_as_float(__builtin_amdgcn_update_dpp(0, __float_as_int(v), 0xB1, 0xF, 0xF, true)); }
__device__ __forceinline__ float dpp_xor2(float v) { return __int_as_float(__builtin_amdgcn_update_dpp(0, __float_as_int(v), 0x4E, 0xF, 0xF, true)); }
__device__ __forceinline__ float dpp_ror4(float v) { return __int_as_float(__builtin_amdgcn_update_dpp(0, __float_as_int(v), 0x124, 0xF, 0xF, true)); }
__device__ __forceinline__ float dpp_ror8(float v) { return __int_as_float(__builtin_amdgcn_update_dpp(0, __float_as_int(v), 0x128, 0xF, 0xF, true)); }
__device__ __forceinline__ int otid() { int t = threadIdx.x; asm volatile("" : "+v"(t)); return t; }
__device__ __forceinline__ float bf2f(u16 h) { return __uint_as_float(((unsigned)h) << 16); }
__device__ __forceinline__ float sigmoidf(float v) { return __builtin_amdgcn_rcpf(1.f + __expf(-v)); }
__device__ __forceinline__ float siluf(float v) { return v * __builtin_amdgcn_rcpf(1.f + __expf(-v)); }
__device__ __forceinline__ float gelu_tanh(float v) {
  float u = 0.7978845608028654f * (v + 0.044715f * v * v * v);
  return v * __builtin_amdgcn_rcpf(1.f + __expf(-2.f * u));
}
__device__ __forceinline__ void unpack8(u32x4 v, float* f) {
  f[0] = __uint_as_float(v.x << 16); f[1] = __uint_as_float(v.x & 0xffff0000u);
  f[2] = __uint_as_float(v.y << 16); f[3] = __uint_as_float(v.y & 0xffff0000u);
  f[4] = __uint_as_float(v.z << 16); f[5] = __uint_as_float(v.z & 0xffff0000u);
  f[6] = __uint_as_float(v.w << 16); f[7] = __uint_as_float(v.w & 0xffff0000u);
}

__device__ __forceinline__ void tr_tile(const float* __restrict__ src, int ld_src, int k0, int n0, u16* __restrict__ dst, int ld_dst,
                        int remap, float* lds) {
  int tid = threadIdx.x;
  int n = tid & 63, kq = tid >> 6;
  int np = n0 + n, sc = np; bool ok = true;
  if (remap) {
    if (np < 2304) sc = np; else if (np < 2816) sc = np + 24; else if (np < 2840) sc = np - 512; else ok = false;
  }
#pragma unroll
  for (int i = 0; i < 16; i++) {
    int k = i * 4 + kq;
    lds[k * 65 + n] = ok ? src[(size_t)(k0 + k) * ld_src + sc] : 0.f;
  }
  __syncthreads();
  int nn = tid >> 2, kk = (tid & 3) * 16;
  u32x4 o0, o1;
  o0.x = pack2(lds[(kk + 0) * 65 + nn], lds[(kk + 1) * 65 + nn]);
  o0.y = pack2(lds[(kk + 2) * 65 + nn], lds[(kk + 3) * 65 + nn]);
  o0.z = pack2(lds[(kk + 4) * 65 + nn], lds[(kk + 5) * 65 + nn]);
  o0.w = pack2(lds[(kk + 6) * 65 + nn], lds[(kk + 7) * 65 + nn]);
  o1.x = pack2(lds[(kk + 8) * 65 + nn], lds[(kk + 9) * 65 + nn]);
  o1.y = pack2(lds[(kk + 10) * 65 + nn], lds[(kk + 11) * 65 + nn]);
  o1.z = pack2(lds[(kk + 12) * 65 + nn], lds[(kk + 13) * 65 + nn]);
  o1.w = pack2(lds[(kk + 14) * 65 + nn], lds[(kk + 15) * 65 + nn]);
  u32x4* d = (u32x4*)(dst + (size_t)(n0 + nn) * ld_dst + k0 + kk);
  d[0] = o0; d[1] = o1;
  __syncthreads();
}

__device__ __forceinline__ void mod_tile(const Params& p, int tile, char* smem) {
  int tid = threadIdx.x;
  float* sc = (float*)smem;
  float* red = (float*)(smem + 8192);
  int ct = tile >> 2, kq = tile & 3;
  for (int i = tid; i < 2048; i += 256) { int b = i >> 8, k = i & 255; float cv = p.c[b * 1024 + kq * 256 + k]; sc[i] = siluf(cv); }
  __syncthreads();
  int col0 = ct * 32, col = tid & 31, ks = tid >> 5;
  float acc[8];
#pragma unroll
  for (int b = 0; b < 8; b++) acc[b] = 0.f;
  float w[32];
#pragma unroll
  for (int k = 0; k < 32; k++) w[k] = p.w_ada[(size_t)(kq * 256 + ks * 32 + k) * 3072 + col0 + col];
#pragma unroll
  for (int k = 0; k < 32; k++) {
#pragma unroll
    for (int b = 0; b < 8; b++) acc[b] += sc[b * 256 + ks * 32 + k] * w[k];
  }
#pragma unroll
  for (int b = 0; b < 8; b++) red[(ks * 8 + b) * 32 + col] = acc[b];
  __syncthreads();
  {
    int b = tid >> 5;
    float s = 0.f;
#pragma unroll
    for (int k2 = 0; k2 < 8; k2++) s += red[(k2 * 8 + b) * 32 + col];
    if (kq == 0) s += p.b_ada[col0 + col];
    atomicAdd(((float*)(p.ws + OFF_MODZ)) + b * 3072 + col0 + col, s);
  }
  __syncthreads();
}

__device__ __forceinline__ void bias1_tile(const Params& p, int i, char* smem) {
  int tid = threadIdx.x;
  int kv = i >> 5, cgp = (i >> 3) & 3, kq = i & 7;
  const float* pos = kv ? p.pos_v : p.pos_k;
  const float* w1 = kv ? p.w1_v : p.w1_k;
  float* red = (float*)smem;
  int col = cgp * 64 + (tid & 63), ks = tid >> 6;
  int kb = kq * 256 + ks * 64;
  float acc = 0.f;
#pragma unroll 1
  for (int k4 = 0; k4 < 4; k4++) {
    float w[16];
#pragma unroll
    for (int e = 0; e < 16; e++) w[e] = w1[(size_t)(kb + k4 * 16 + e) * 256 + col];
#pragma unroll
    for (int e = 0; e < 16; e++) acc += pos[kb + k4 * 16 + e] * w[e];
  }
  red[tid] = acc;
  __syncthreads();
  if (tid < 64) ((float*)(p.ws + OFF_B1S))[kq * 512 + kv * 256 + col] = (red[tid] + red[tid + 64]) + (red[tid + 128] + red[tid + 192]);
  __syncthreads();
}

__device__ __forceinline__ void phase0(const Params& p, char* smem) {
  float* lds = (float*)smem;
  for (int t = blockIdx.x; t < 1720; t += gridDim.x) {
    if (t < 384) mod_tile(p, t, smem);
    else if (t < 1120) { int i = t - 384; tr_tile(p.w_in, 2840, (i / 46) * 64, (i % 46) * 64, ((u16*)(p.ws + OFF_winT)), 1024, 1, lds); }
    else if (t < 1376) { int i = t - 1120; tr_tile(p.w_out, 1024, (i >> 4) * 64, (i & 15) * 64, ((u16*)(p.ws + OFF_woutT)), 1024, 0, lds); }
    else if (t < 1504) { int i = t - 1376; tr_tile(p.w1_k, 256, (i >> 2) * 64, (i & 3) * 64, ((u16*)(p.ws + OFF_w1T0)), 2048, 0, lds); }
    else if (t < 1632) { int i = t - 1504; tr_tile(p.w1_v, 256, (i >> 2) * 64, (i & 3) * 64, ((u16*)(p.ws + OFF_w1T1)), 2048, 0, lds); }
    else if (t < 1636) { int i = t - 1632; tr_tile(p.w2_k, 64, i * 64, 0, ((u16*)(p.ws + OFF_w2T0)), 256, 0, lds); }
    else if (t < 1640) { int i = t - 1636; tr_tile(p.w2_v, 64, i * 64, 0, ((u16*)(p.ws + OFF_w2T1)), 256, 0, lds); }
    else if (t < 1648) { int i = t - 1640; tr_tile(p.w_rg_a + i * 4096, 64, 0, 0, ((u16*)(p.ws + OFF_waT)) + i * 4096, 64, 0, lds); }
    else if (t < 1656) { int i = t - 1648; tr_tile(p.w_rg_x + i * 4096, 64, 0, 0, ((u16*)(p.ws + OFF_wxT)) + i * 4096, 64, 0, lds); }
    else bias1_tile(p, t - 1656, smem);
  }
  f32x4 z = {0.f, 0.f, 0.f, 0.f};
  for (int i = blockIdx.x * 256 + threadIdx.x; i < 131072; i += gridDim.x * 256) ((f32x4*)((float*)(p.ws + OFF_CACC)))[i] = z;
}

__device__ __forceinline__ void phase1(const Params& p, char* smem) {
  int lane = threadIdx.x & 63, wave = threadIdx.x >> 6;
  f32x4 v[4][4], nv[4][4];
  int tile = blockIdx.x;
  if (tile < 2048) {
#pragma unroll
    for (int tt = 0; tt < 4; tt++)
#pragma unroll
      for (int i = 0; i < 4; i++) v[tt][i] = __builtin_nontemporal_load((const f32x4*)(p.x + (size_t)(tile * 16 + wave * 4 + tt) * 1024 + i * 256 + lane * 4));
  }
  for (; tile < 2048; tile += gridDim.x) {
    int tokb = tile * 16 + wave * 4;
    int b = tokb >> 12;
    int ntile = tile + gridDim.x;
    if (ntile < 2048) {
#pragma unroll
      for (int tt = 0; tt < 4; tt++)
#pragma unroll
        for (int i = 0; i < 4; i++) nv[tt][i] = __builtin_nontemporal_load((const f32x4*)(p.x + (size_t)(ntile * 16 + wave * 4 + tt) * 1024 + i * 256 + lane * 4));
    }
    const float* md = ((float*)(p.ws + OFF_MODZ)) + b * 3072;
    f32x4 g[4], sh[4];
#pragma unroll
    for (int i = 0; i < 4; i++) {
      int k = i * 256 + lane * 4;
      g[i] = *(const f32x4*)(p.norm_g + k);
      sh[i] = *(const f32x4*)(md + k);
      f32x4 sc = *(const f32x4*)(md + 1024 + k);
      g[i] = g[i] * (1.f + sc);
    }
#pragma unroll
    for (int tt = 0; tt < 4; tt++) {
      float ss = 0.f;
#pragma unroll
      for (int i = 0; i < 4; i++) ss += v[tt][i].x * v[tt][i].x + v[tt][i].y * v[tt][i].y + v[tt][i].z * v[tt][i].z + v[tt][i].w * v[tt][i].w;
      { ss += dpp_xor1(ss); ss += dpp_xor2(ss); ss += dpp_ror4(ss); ss += dpp_ror8(ss); ss += __shfl_xor(ss, 16); ss += __shfl_xor(ss, 32); }
      float rstd = rsqrtf(ss * (1.f / 1024.f) + EPSF);
#pragma unroll
      for (int i = 0; i < 4; i++) {
        int k = i * 256 + lane * 4;
        f32x4 h = v[tt][i] * rstd * g[i] + sh[i];
        u32x2 o; o.x = pack2(h.x, h.y); o.y = pack2(h.z, h.w);
        *(u32x2*)(((u16*)(p.ws + OFF_H)) + (size_t)(tokb + tt) * 1024 + k) = o;
      }
    }
#pragma unroll
    for (int tt = 0; tt < 4; tt++)
#pragma unroll
      for (int i = 0; i < 4; i++) v[tt][i] = nv[tt][i];
  }
}

struct GemmArgs { const u16* A; size_t a_rs; size_t a_ks; const u16* B; size_t b_rs; int nk; };

__device__ __forceinline__ void glds16(const u16* g, char* l) {
  __builtin_amdgcn_global_load_lds((const unsigned*)g, (unsigned*)l, 16, 0, 0);
}
__device__ __forceinline__ void gemm_main(const GemmArgs& g, char* smem, f32x16 (&acc)[2][2]) {
  int tid = otid(), lane = tid & 63, wave = tid >> 6, wm = wave >> 1, wn = wave & 1;
  int r0 = tid >> 3, lch = (tid & 7) ^ ((tid >> 4) & 7);
  const u16* ap = g.A + (size_t)r0 * g.a_rs + lch * 8;
  const u16* bp = g.B + (size_t)r0 * g.b_rs + lch * 8;
  size_t astep = 32 * g.a_rs, bstep = 32 * g.b_rs;
  int so = tid * 16;
#pragma unroll
  for (int mt = 0; mt < 2; mt++)
#pragma unroll
    for (int nt = 0; nt < 2; nt++)
#pragma unroll
      for (int e = 0; e < 16; e++) acc[mt][nt][e] = 0.f;
#pragma unroll
  for (int i = 0; i < 4; i++) { glds16(ap + i * astep, smem + so + i * 4096); glds16(bp + i * bstep, smem + 16384 + so + i * 4096); }
  __syncthreads();
  int l31 = lane & 31, lh = lane >> 5;
  int sw = (l31 >> 1) & 7;
  int aoff = (wm * 64 + l31) * 128, boff = 16384 + (wn * 64 + l31) * 128;
  for (int kt = 0; kt < g.nk; kt++) {
    bool more = (kt + 1 < g.nk);
    if (more) {
      ap += g.a_ks; bp += 64;
      char* Wn = smem + ((kt + 1) & 1) * 32768;
#pragma unroll
      for (int i = 0; i < 4; i++) { glds16(ap + i * astep, Wn + so + i * 4096); glds16(bp + i * bstep, Wn + 16384 + so + i * 4096); }
    }
    __builtin_amdgcn_sched_barrier(0);
    const char* Ls = smem + (kt & 1) * 32768;
    {
      bf16x8 fa[2][2], fb[2][2];
      {
        int off = ((lh ^ sw) << 4);
#pragma unroll
        for (int mt = 0; mt < 2; mt++) fa[0][mt] = *(const bf16x8*)(Ls + aoff + mt * 4096 + off);
#pragma unroll
        for (int nt = 0; nt < 2; nt++) fb[0][nt] = *(const bf16x8*)(Ls + boff + nt * 4096 + off);
      }
#pragma unroll
      for (int ks = 0; ks < 4; ks++) {
        if (ks < 3) {
          int off = ((((ks + 1) * 2 + lh) ^ sw) << 4);
#pragma unroll
          for (int mt = 0; mt < 2; mt++) fa[(ks + 1) & 1][mt] = *(const bf16x8*)(Ls + aoff + mt * 4096 + off);
#pragma unroll
          for (int nt = 0; nt < 2; nt++) fb[(ks + 1) & 1][nt] = *(const bf16x8*)(Ls + boff + nt * 4096 + off);
        }
#pragma unroll
        for (int mt = 0; mt < 2; mt++)
#pragma unroll
          for (int nt = 0; nt < 2; nt++)
            acc[mt][nt] = __builtin_amdgcn_mfma_f32_32x32x16_bf16(fa[ks & 1][mt], fb[ks & 1][nt], acc[mt][nt], 0, 0, 0);
        __builtin_amdgcn_sched_barrier(0);
      }
    }
    __syncthreads();
  }
}

#define CROW(reg, lh) (((reg) & 3) + 8 * ((reg) >> 2) + 4 * (lh))
#define CLD 136

__device__ __forceinline__ void stage_c(char* smem, const f32x16 (&acc)[2][2], int wm, int wn, int lane) {
  u16* C = (u16*)smem;
  int l31 = lane & 31, lh = lane >> 5;
#pragma unroll
  for (int mt = 0; mt < 2; mt++)
#pragma unroll
    for (int nt = 0; nt < 2; nt++)
#pragma unroll
      for (int e = 0; e < 16; e++) {
        int row = wm * 64 + mt * 32 + CROW(e, lh);
        int col = wn * 64 + nt * 32 + l31;
        C[row * CLD + col] = f2bf(acc[mt][nt][e]);
      }
}

__device__ __forceinline__ void copy_rows(const char* smem, int hf, u16* dst, size_t ld) {
  const u16* C = (const u16*)smem;
  int tid = threadIdx.x, sub = tid & 7, r0 = tid >> 3;
#pragma unroll
  for (int ps = 0; ps < 4; ps++) {
    int r = r0 + ps * 32;
    u32x4 v = *(const u32x4*)(C + r * CLD + hf * 64 + sub * 8);
    *(u32x4*)(dst + (size_t)r * ld + sub * 8) = v;
  }
}
__device__ __forceinline__ void copy_transposed(const char* smem, int hf, u16* dst  ) {
  const u16* C = (const u16*)smem;
  int tid = threadIdx.x, d = tid >> 2, tq = tid & 3;
  unsigned w[16];
#pragma unroll
  for (int i = 0; i < 16; i++) {
    int pp = 2 * i;
    int ii = ((pp >> 2) & 1) * 16 + (pp >> 3) * 4 + (pp & 3);
    unsigned lo = C[(tq * 32 + ii) * CLD + hf * 64 + d];
    unsigned hi = C[(tq * 32 + ii + 1) * CLD + hf * 64 + d];
    w[i] = lo | (hi << 16);
  }
  u32x4* o = (u32x4*)(dst + (size_t)d * SEQ + tq * 32);
  u32x4 a = {w[0], w[1], w[2], w[3]}, b = {w[4], w[5], w[6], w[7]}, c = {w[8], w[9], w[10], w[11]}, e = {w[12], w[13], w[14], w[15]};
  o[0] = a; o[1] = b; o[2] = c; o[3] = e;
}

__device__ __forceinline__ void gemm_in_tile(const Params& p, int tm, int tn, char* smem) {
  int tid = otid(), lane = tid & 63, wave = tid >> 6, wm = wave >> 1, wn = wave & 1;
  GemmArgs g;
  g.A = ((u16*)(p.ws + OFF_H)) + (size_t)tm * 128 * 1024; g.a_rs = 1024; g.a_ks = 64;
  g.B = ((u16*)(p.ws + OFF_winT)) + (size_t)tn * 128 * 1024; g.b_rs = 1024; g.nk = 16;
  f32x16 acc[2][2];
  gemm_main(g, smem, acc);
  int tok0 = tm * 128, b = tok0 >> 12, t0 = tok0 & 4095;
  int cb = tn * 2 + wn;
  int l31 = lane & 31, lh = lane >> 5;
  const float* gam = nullptr; float qs = 1.f;
  if (cb >= 16 && cb < 24) { gam = p.g_q; qs = 0.125f * 1.4426950408889634f; }
  else if (cb == 28 || cb == 29) gam = p.g_ks;
  else if (cb == 32 || cb == 33) gam = p.g_kw;
  if (gam) {
    float g0 = gam[l31] * qs, g1 = gam[32 + l31] * qs;
#pragma unroll
    for (int mt = 0; mt < 2; mt++)
#pragma unroll
      for (int e = 0; e < 16; e++) {
        float v = acc[mt][0][e] * acc[mt][0][e] + acc[mt][1][e] * acc[mt][1][e];
        v += dpp_xor1(v); v += dpp_xor2(v); v += dpp_ror4(v); v += dpp_ror8(v); v += __shfl_xor(v, 16);
        float rstd = rsqrtf(v * (1.f / 64.f) + EPSF);
        acc[mt][0][e] *= rstd * g0; acc[mt][1][e] *= rstd * g1;
      }
  }
  if (cb == 44) {
    if (l31 < 24) {
#pragma unroll
      for (int mt = 0; mt < 2; mt++)
#pragma unroll
        for (int e = 0; e < 16; e++) {
          int row = wm * 64 + mt * 32 + CROW(e, lh);
          ((float*)(p.ws + OFF_GS))[(size_t)(tok0 + row) * 24 + l31] = sigmoidf(acc[mt][0][e]);
        }
    }
  }
  stage_c(smem, acc, wm, wn, lane);
  __syncthreads();
#pragma unroll 1
  for (int hf = 0; hf < 2; hf++) {
    int c2 = tn * 2 + hf;
    if (c2 < 16) copy_rows(smem, hf, ((u16*)(p.ws + OFF_XZ)) + (size_t)tok0 * 1024 + c2 * 64, 1024);
    else if (c2 < 24) copy_rows(smem, hf, ((u16*)(p.ws + OFF_Q)) + (size_t)tok0 * 512 + (c2 - 16) * 64, 512);
    else if (c2 < 28) copy_rows(smem, hf, ((u16*)(p.ws + OFF_KVC)) + (size_t)tok0 * 256 + (c2 - 24) * 64, 256);
    else if (c2 < 30) copy_rows(smem, hf, ((u16*)(p.ws + OFF_KS)) + ((size_t)(b * 2 + (c2 - 28)) * SEQ + t0) * 64, 64);
    else if (c2 < 32) copy_transposed(smem, hf, ((u16*)(p.ws + OFF_VST)) + (size_t)(b * 2 + (c2 - 30)) * 64 * SEQ + t0);
    else if (c2 < 34) copy_rows(smem, hf, ((u16*)(p.ws + OFF_KW)) + ((size_t)(b * 2 + (c2 - 32)) * SEQ + t0) * 64, 64);
    else if (c2 < 36) copy_transposed(smem, hf, ((u16*)(p.ws + OFF_VWT)) + (size_t)(b * 2 + (c2 - 34)) * 64 * SEQ + t0);
    else if (c2 < 44) copy_rows(smem, hf, ((u16*)(p.ws + OFF_ZN)) + (size_t)tok0 * 512 + (c2 - 36) * 64, 512);
  }
  __syncthreads();
}

__device__ __forceinline__ void phase2(const Params& p, char* smem) {
  int xcd = blockIdx.x & 7, loc = blockIdx.x >> 3, nloc = gridDim.x >> 3;
  for (int v = loc; v < 12 * 64; v += nloc) {
    int st = (v >> 6) * 8 + xcd, w = v & 63;
    int tm = (st / 3) * 8 + (w & 7), tn = (st % 3) * 8 + (w >> 3);
    if (tn < 23) gemm_in_tile(p, tm, tn, smem);
  }
}

__device__ __forceinline__ void compress_tile(const Params& p, int idx, char* smem) {
  int tid = otid(), lane = tid & 63, wave = tid >> 6, wm = wave >> 1, wn = wave & 1;
  int ch = idx & 1, rh = (idx >> 1) & 1, bh = (idx >> 2) & 15, kv = idx >> 6;
  int b = bh >> 1, hk = bh & 1;
  GemmArgs g;
  g.A = ((u16*)(p.ws + OFF_KVC)) + ((size_t)(b * SEQ + 16 * rh * 128)) * 256 + kv * 128 + hk * 64; g.a_rs = 16 * 256; g.a_ks = 256;
  g.B = (kv ? ((u16*)(p.ws + OFF_w1T1)) : ((u16*)(p.ws + OFF_w1T0))) + (size_t)ch * 128 * 2048; g.b_rs = 2048; g.nk = 32;
  f32x16 acc[2][2];
  gemm_main(g, smem, acc);
  int l31 = lane & 31, lh = lane >> 5;
  const float* b1 = ((float*)(p.ws + OFF_B1S)) + kv * 256 + ch * 128 + wn * 64;
  float bb0 = 0.f, bb1 = 0.f;
#pragma unroll
  for (int kq = 0; kq < 8; kq++) { bb0 += b1[kq * 512 + l31]; bb1 += b1[kq * 512 + 32 + l31]; }
#pragma unroll
  for (int mt = 0; mt < 2; mt++)
#pragma unroll
    for (int e = 0; e < 16; e++) {
      acc[mt][0][e] = gelu_tanh(acc[mt][0][e] + bb0);
      acc[mt][1][e] = gelu_tanh(acc[mt][1][e] + bb1);
    }
  stage_c(smem, acc, wm, wn, lane);
  __syncthreads();
  const u16* C = (const u16*)smem;
  const u16* w2 = (kv ? ((u16*)(p.ws + OFF_w2T1)) : ((u16*)(p.ws + OFF_w2T0))) + ch * 128;
  f32x16 o2[2];
#pragma unroll
  for (int nt = 0; nt < 2; nt++)
#pragma unroll
    for (int e = 0; e < 16; e++) o2[nt][e] = 0.f;
#pragma unroll
  for (int ks = 0; ks < 8; ks++) {
    bf16x8 a = *(const bf16x8*)(C + (wave * 32 + l31) * CLD + ks * 16 + lh * 8);
#pragma unroll
    for (int nt = 0; nt < 2; nt++) {
      bf16x8 bw = *(const bf16x8*)(w2 + (size_t)(nt * 32 + l31) * 256 + ks * 16 + lh * 8);
      o2[nt] = __builtin_amdgcn_mfma_f32_32x32x16_bf16(a, bw, o2[nt], 0, 0, 0);
    }
  }
  float* dst = ((float*)(p.ws + OFF_CACC)) + (size_t)kv * 262144 + ((size_t)bh * 256 + rh * 128 + wave * 32) * 64;
#pragma unroll
  for (int nt = 0; nt < 2; nt++)
#pragma unroll
    for (int e = 0; e < 16; e++) atomicAdd(dst + CROW(e, lh) * 64 + nt * 32 + l31, o2[nt][e]);
  __syncthreads();
}

struct LruIn { u32x4 x[2][4]; };
struct LruW { f32x4 cw[4][2]; f32x4 cbs[2]; float gba[4], gbx[4], sp[4]; };
__device__ __forceinline__ void lru_load_w(const Params& p, int n, LruW& W) {
  int tid = otid(), lane = tid & 63;
  int ch8 = tid & 7, l15 = lane & 15;
#pragma unroll
  for (int j = 0; j < 4; j++) {
    W.cw[j][0] = *(const f32x4*)(p.conv_w + j * 512 + n * 64 + ch8 * 8);
    W.cw[j][1] = *(const f32x4*)(p.conv_w + j * 512 + n * 64 + ch8 * 8 + 4);
  }
  W.cbs[0] = *(const f32x4*)(p.conv_b + n * 64 + ch8 * 8);
  W.cbs[1] = *(const f32x4*)(p.conv_b + n * 64 + ch8 * 8 + 4);
#pragma unroll
  for (int nt = 0; nt < 4; nt++) {
    int chn = n * 64 + nt * 16 + l15;
    W.gba[nt] = p.b_rg_a[chn]; W.gbx[nt] = p.b_rg_x[chn];
    float ee = __expf(-p.lam[chn]);
    W.sp[nt] = (ee < 0.0625f) ? ee * (1.f + ee * (-0.5f + ee * (0.33333334f + ee * (-0.25f + ee * 0.2f)))) : __logf(1.f + ee);
  }
}
__device__ __forceinline__ void lru_load(const Params& p, int idx, LruIn& L) {
  int tid = otid();
  int n = idx & 7, c = (idx >> 3) & 63, b = idx >> 9;
  int t0 = c * 64, ch8 = tid & 7, tr = tid >> 3;
#pragma unroll
  for (int ps = 0; ps < 2; ps++)
#pragma unroll
    for (int j = 0; j < 4; j++) {
      int ts = t0 + tr + ps * 32 - 3 + j;
      int tsc = ts < 0 ? 0 : ts;
      L.x[ps][j] = *(const u32x4*)(((u16*)(p.ws + OFF_XZ)) + ((size_t)(b * SEQ + tsc)) * 1024 + n * 64 + ch8 * 8);
    }
  __builtin_amdgcn_sched_barrier(0);
}
__device__ __forceinline__ void lru_local_tile(const Params& p, int idx, char* smem, const LruIn& Lin, const LruW& W) {
  int tid = otid(), lane = tid & 63, wave = tid >> 6;
  int n = idx & 7, c = (idx >> 3) & 63, b = idx >> 9;
  float* xcf = (float*)smem;
  char* xcb = smem + 16384;
  float* a_s = (float*)(smem + 24576);
  float* u_s = (float*)(smem + 40960);
  float* endA = (float*)(smem + 57344);
  float* endH = endA + 256;
  int t0 = c * 64;
  int l15 = lane & 15, lq = lane >> 4;
  int ch8 = tid & 7, tr = tid >> 3;
  u32x4 xin[2][4];
#pragma unroll
  for (int ps = 0; ps < 2; ps++)
#pragma unroll
    for (int j = 0; j < 4; j++) {
      int ts = t0 + tr + ps * 32 - 3 + j;
      xin[ps][j] = (ts < 0) ? (u32x4){0u, 0u, 0u, 0u} : Lin.x[ps][j];
    }
  bf16x8 wfa[2][4], wfx[2][4];
  {
    const u16* wa = ((u16*)(p.ws + OFF_waT)) + n * 4096;
    const u16* wx = ((u16*)(p.ws + OFF_wxT)) + n * 4096;
#pragma unroll
    for (int ks = 0; ks < 2; ks++)
#pragma unroll
      for (int nt = 0; nt < 4; nt++) {
        wfa[ks][nt] = *(const bf16x8*)(wa + (nt * 16 + l15) * 64 + ks * 32 + lq * 8);
        wfx[ks][nt] = *(const bf16x8*)(wx + (nt * 16 + l15) * 64 + ks * 32 + lq * 8);
      }
  }
  __builtin_amdgcn_sched_barrier(0);
#pragma unroll
  for (int ps = 0; ps < 2; ps++) {
    int tl = tr + ps * 32;
    float y[8];
    y[0] = W.cbs[0].x; y[1] = W.cbs[0].y; y[2] = W.cbs[0].z; y[3] = W.cbs[0].w; y[4] = W.cbs[1].x; y[5] = W.cbs[1].y; y[6] = W.cbs[1].z; y[7] = W.cbs[1].w;
#pragma unroll
    for (int j = 0; j < 4; j++) {
      float f[8]; unpack8(xin[ps][j], f);
      y[0] += W.cw[j][0].x * f[0]; y[1] += W.cw[j][0].y * f[1]; y[2] += W.cw[j][0].z * f[2]; y[3] += W.cw[j][0].w * f[3];
      y[4] += W.cw[j][1].x * f[4]; y[5] += W.cw[j][1].y * f[5]; y[6] += W.cw[j][1].z * f[6]; y[7] += W.cw[j][1].w * f[7];
    }
    *(f32x4*)(xcf + tl * 64 + ch8 * 8) = (f32x4){y[0], y[1], y[2], y[3]};
    *(f32x4*)(xcf + tl * 64 + ch8 * 8 + 4) = (f32x4){y[4], y[5], y[6], y[7]};
    u32x4 o; o.x = pack2(y[0], y[1]); o.y = pack2(y[2], y[3]); o.z = pack2(y[4], y[5]); o.w = pack2(y[6], y[7]);
    *(u32x4*)(xcb + tl * 128 + ((ch8 ^ ((tl >> 1) & 7)) << 4)) = o;
  }
  __syncthreads();
  {
    f32x4 ar[4], ai[4];
#pragma unroll
    for (int nt = 0; nt < 4; nt++) { ar[nt] = (f32x4){0.f, 0.f, 0.f, 0.f}; ai[nt] = (f32x4){0.f, 0.f, 0.f, 0.f}; }
#pragma unroll
    for (int ks = 0; ks < 2; ks++) {
      int row = wave * 16 + l15, chk = ks * 4 + lq;
      bf16x8 av = *(const bf16x8*)(xcb + row * 128 + ((chk ^ ((row >> 1) & 7)) << 4));
#pragma unroll
      for (int nt = 0; nt < 4; nt++) {
        ar[nt] = __builtin_amdgcn_mfma_f32_16x16x32_bf16(av, wfa[ks][nt], ar[nt], 0, 0, 0);
        ai[nt] = __builtin_amdgcn_mfma_f32_16x16x32_bf16(av, wfx[ks][nt], ai[nt], 0, 0, 0);
      }
    }
#pragma unroll
    for (int nt = 0; nt < 4; nt++) {
      int j = nt * 16 + l15;
      float sp = W.sp[nt];
#pragma unroll
      for (int r = 0; r < 4; r++) {
        int tl = wave * 16 + lq * 4 + r;
        float rg = sigmoidf(ar[nt][r] + W.gba[nt]);
        float ig = sigmoidf(ai[nt][r] + W.gbx[nt]);
        float la = -8.f * rg * sp;
        float av = __expf(la);
        float x2 = 2.f * la;
        float om_s = -x2 * (1.f + x2 * (0.5f + x2 * (0.16666667f + x2 * (0.041666668f + x2 * 0.0083333338f))));
        float om_b = fmaf(-av, av, 1.f);
        float om = (x2 > -0.25f) ? om_s : om_b;
        float mult = __builtin_amdgcn_sqrtf(fmaxf(om, 0.f));
        float uv = mult * ig * xcf[tl * 64 + j];
        a_s[tl * 64 + j] = av;
        u_s[tl * 64 + j] = uv;
      }
    }
  }
  __syncthreads();
  int sub = tid >> 6, chl = tid & 63;
  float hs[16], cs[16];
  {
    float avv[16], uvv[16];
#pragma unroll
    for (int i = 0; i < 16; i++) { int tl = sub * 16 + i; avv[i] = a_s[tl * 64 + chl]; uvv[i] = u_s[tl * 64 + chl]; }
    __builtin_amdgcn_sched_barrier(0);
    float h = 0.f, cum = 1.f;
#pragma unroll
    for (int i = 0; i < 16; i++) { h = avv[i] * h + uvv[i]; cum *= avv[i]; hs[i] = h; cs[i] = cum; }
    endA[sub * 64 + chl] = cum; endH[sub * 64 + chl] = h;
  }
  __syncthreads();
  {
    float e0a = endA[chl], e0h = endH[chl], e1a = endA[64 + chl], e1h = endH[64 + chl], e2a = endA[128 + chl], e2h = endH[128 + chl];
    float Ain = 1.f, Hin = 0.f;
    if (sub > 0) { Hin = e0h; Ain = e0a; }
    if (sub > 1) { Hin = e1a * Hin + e1h; Ain *= e1a; }
    if (sub > 2) { Hin = e2a * Hin + e2h; Ain *= e2a; }
    float hl = 0.f, ct = 0.f;
#pragma unroll
    for (int i = 0; i < 16; i++) {
      int tl = sub * 16 + i;
      hl = hs[i] + cs[i] * Hin; ct = cs[i] * Ain;
      u_s[tl * 64 + chl] = hl; a_s[tl * 64 + chl] = ct;
    }
    if (sub == 3) {
      float* ce = ((float*)(p.ws + OFF_CE)) + ((size_t)(b * 64 + c) * 512 + n * 64 + chl) * 2;
      *(f2_t*)ce = (f2_t){ct, hl};
    }
  }
  __syncthreads();
#pragma unroll
  for (int ps = 0; ps < 2; ps++) {
    int tl = tr + ps * 32;
    size_t o = ((size_t)(b * SEQ + t0 + tl)) * 512 + n * 64 + ch8 * 8;
    f32x4 h0 = *(const f32x4*)(u_s + tl * 64 + ch8 * 8), h1 = *(const f32x4*)(u_s + tl * 64 + ch8 * 8 + 4);
    f32x4 c0 = *(const f32x4*)(a_s + tl * 64 + ch8 * 8), c1 = *(const f32x4*)(a_s + tl * 64 + ch8 * 8 + 4);
    u32x4 ho, co;
    ho.x = pack2(h0.x, h0.y); ho.y = pack2(h0.z, h0.w); ho.z = pack2(h1.x, h1.y); ho.w = pack2(h1.z, h1.w);
    co.x = pack2(c0.x, c0.y); co.y = pack2(c0.z, c0.w); co.z = pack2(c1.x, c1.y); co.w = pack2(c1.z, c1.w);
    *(u32x4*)(((u16*)(p.ws + OFF_HL)) + o) = ho;
    *(u32x4*)(((u16*)(p.ws + OFF_CA)) + o) = co;
  }
  __syncthreads();
}

__device__ __forceinline__ void phase3(const Params& p, char* smem, int tstart) {
  int blk = blockIdx.x, nb = gridDim.x;
  int first, stride, cnt;
  if (nb == 512) {
    if (blk < 128) { if (tstart == 0) compress_tile(p, blk, smem); first = blk; stride = 128; cnt = 4; }
    else { first = 512 + (blk - 128); stride = 384; cnt = (4096 - first + 383) / 384; }
  } else {
    for (int tile = tstart + blk; tile < 128; tile += nb) compress_tile(p, tile, smem);
    first = blk; stride = nb; cnt = (4096 - first + nb - 1) / nb;
    if (first >= 4096) cnt = 0;
  }
  if (cnt > 0) {
    LruIn cur, nxt;
    LruW W;
    int nW = first & 7;
    lru_load_w(p, nW, W);
    lru_load(p, first, cur);
    for (int i = 0; i < cnt; i++) {
      int t = first + i * stride;
      int tn = (i + 1 < cnt) ? t + stride : t;
      if ((t & 7) != nW) { nW = t & 7; lru_load_w(p, nW, W); }
      lru_load(p, tn, nxt);
      lru_local_tile(p, t, smem, cur, W);
      cur = nxt;
    }
  }
}

__device__ __forceinline__ void phase3b(const Params& p, char* smem) {
  int tid = otid();
  for (int tile = blockIdx.x; tile < 48; tile += gridDim.x) {
    if (tile >= 32) {
      int b = (tile - 32) >> 1, ch = ((tile - 32) & 1) * 256 + tid;
      const float* ce = ((const float*)(p.ws + OFF_CE)) + ((size_t)b * 64 * 512 + ch) * 2;
      float* cin = ((float*)(p.ws + OFF_CIN)) + (size_t)b * 64 * 512 + ch;
      float carry = 0.f;
#pragma unroll 1
      for (int c2 = 0; c2 < 2; c2++) {
        u32x2 v[32];
#pragma unroll
        for (int e = 0; e < 32; e++) v[e] = *(const u32x2*)(ce + (size_t)(c2 * 32 + e) * 1024);
        __builtin_amdgcn_sched_barrier(0);
#pragma unroll
        for (int e = 0; e < 32; e++) {
          cin[(size_t)(c2 * 32 + e) * 512] = carry;
          carry = __uint_as_float(v[e].x) * carry + __uint_as_float(v[e].y);
        }
      }
      continue;
    }
    int kv = tile >> 4, bh = tile & 15;
    const float* src = ((float*)(p.ws + OFF_CACC)) + (size_t)kv * 262144 + (size_t)bh * 256 * 64;
    if (kv == 0) {
      int ch = tid & 7;
      f32x4 ga = *(const f32x4*)(p.g_kc + ch * 8), gb = *(const f32x4*)(p.g_kc + ch * 8 + 4);
      f32x4 v0[8], v1[8];
#pragma unroll
      for (int ps = 0; ps < 8; ps++) {
        int r = (tid >> 3) + ps * 32;
        v0[ps] = *(const f32x4*)(src + r * 64 + ch * 8); v1[ps] = *(const f32x4*)(src + r * 64 + ch * 8 + 4);
      }
      __builtin_amdgcn_sched_barrier(0);
#pragma unroll
      for (int ps = 0; ps < 8; ps++) {
        int r = (tid >> 3) + ps * 32;
        f32x4 a0 = v0[ps], a1 = v1[ps];
        float ss = a0.x * a0.x + a0.y * a0.y + a0.z * a0.z + a0.w * a0.w + a1.x * a1.x + a1.y * a1.y + a1.z * a1.z + a1.w * a1.w;
        ss += dpp_xor1(ss); ss += dpp_xor2(ss); ss += __shfl_xor(ss, 4);
        float rstd = rsqrtf(ss * (1.f / 64.f) + EPSF);
        u32x4 o;
        o.x = pack2(a0.x * rstd * ga.x, a0.y * rstd * ga.y); o.y = pack2(a0.z * rstd * ga.z, a0.w * rstd * ga.w);
        o.z = pack2(a1.x * rstd * gb.x, a1.y * rstd * gb.y); o.w = pack2(a1.z * rstd * gb.z, a1.w * rstd * gb.w);
        *(u32x4*)(((u16*)(p.ws + OFF_KCN)) + ((size_t)bh * 256 + r) * 64 + ch * 8) = o;
      }
    } else {
      int d = tid >> 2, iq = tid & 3;
      u16* dst = ((u16*)(p.ws + OFF_VCT)) + ((size_t)bh * 64 + d) * 256 + iq * 64;
      float f[64];
#pragma unroll
      for (int pp = 0; pp < 64; pp++) {
        int i = iq * 64 + (pp >> 5) * 32 + ((pp >> 2) & 1) * 16 + ((pp >> 3) & 3) * 4 + (pp & 3);
        int ic = i < 255 ? i : 254;
        f[pp] = src[ic * 64 + d];
        if (i >= 255) f[pp] = 0.f;
      }
      __builtin_amdgcn_sched_barrier(0);
#pragma unroll
      for (int c8 = 0; c8 < 8; c8++) {
        u32x4 o; o.x = pack2(f[c8 * 8 + 0], f[c8 * 8 + 1]); o.y = pack2(f[c8 * 8 + 2], f[c8 * 8 + 3]); o.z = pack2(f[c8 * 8 + 4], f[c8 * 8 + 5]); o.w = pack2(f[c8 * 8 + 6], f[c8 * 8 + 7]);
        *(u32x4*)(dst + c8 * 8) = o;
      }
    }
  }
}

#define SOFF 16.f
template <int MODE>
__device__ __forceinline__ void flash_tile(const char* Kl, const char* Vl, const bf16x8 (&qf)[2], f32x4 (&O)[4], float& l,
                                           int j, int t, int t0, float slope2, bool rowsel, int lane, f32x4 (&sout)[4]) {
  int l15 = lane & 15, lq = lane >> 4;
  float cl, step;
  if (MODE == 2) { cl = slope2 * (float)(16 * (j * 64 + lq * 4) + 31 - t) - SOFF; step = slope2 * 16.f; }
  else { cl = slope2 * (float)(j * 64 + lq * 4 - t) - SOFF; step = slope2; }
  if (MODE == 0 && !rowsel) cl = -1e30f;
  f32x4 s[4];
  int sw = (l15 >> 1) & 7;
#pragma unroll
  for (int mt = 0; mt < 4; mt++)
#pragma unroll
    for (int r = 0; r < 4; r++) s[mt][r] = cl + step * (float)(mt * 16 + r);
  bf16x8 va[2][4];
  {
    bf16x8 ka[2][4];
#pragma unroll
    for (int ks = 0; ks < 2; ks++)
#pragma unroll
      for (int mt = 0; mt < 4; mt++) ka[ks][mt] = *(const bf16x8*)(Kl + (mt * 16 + l15) * 128 + (((ks * 4 + lq) ^ sw) << 4));
    __builtin_amdgcn_sched_barrier(0);
#pragma unroll
    for (int ks = 0; ks < 2; ks++)
#pragma unroll
      for (int mt = 0; mt < 4; mt++) s[mt] = __builtin_amdgcn_mfma_f32_16x16x32_bf16(ka[ks][mt], qf[ks], s[mt], 0, 0, 0);
#pragma unroll
    for (int kk = 0; kk < 2; kk++)
#pragma unroll
      for (int mt = 0; mt < 4; mt++) va[kk][mt] = *(const bf16x8*)(Vl + (mt * 16 + l15) * 128 + (((kk * 4 + lq) ^ sw) << 4));
    __builtin_amdgcn_sched_barrier(0);
  }
  bool need;
  if (MODE == 0) need = (j == (t0 >> 6));
  else if (MODE == 1) need = (j == (t0 >> 6)) || (j * 64 <= t0 - 497);
  else need = ((j * 64 + 63) * 16 + 31 > t0) || (j == 3);
  if (need) {
    { float t0v = s[0][0]; asm volatile("" : "+v"(t0v)); s[0][0] = t0v; }
#pragma unroll
    for (int mt = 0; mt < 4; mt++)
#pragma unroll
      for (int r = 0; r < 4; r++) {
        int kidx = j * 64 + mt * 16 + lq * 4 + r;
        bool valid;
        if (MODE == 0) valid = (t - kidx) >= 0;
        else if (MODE == 1) { int d = t - kidx; valid = d >= 0 && d < 512; }
        else valid = (t - (16 * kidx + 31)) >= 0 && kidx < 255;
        s[mt][r] = valid ? s[mt][r] : -1e30f;
      }
  }
  if (MODE == 2) {
#pragma unroll
    for (int mt = 0; mt < 4; mt++) sout[mt] = s[mt];
  }
  f32x4 ps = {0.f, 0.f, 0.f, 0.f};
#pragma unroll
  for (int mt = 0; mt < 4; mt++) {
#pragma unroll
    for (int r = 0; r < 4; r++) s[mt][r] = __builtin_amdgcn_exp2f(s[mt][r]);
    ps += s[mt];
  }
  l += (ps[0] + ps[1]) + (ps[2] + ps[3]);
#pragma unroll
  for (int kk = 0; kk < 2; kk++) {
    union { bf16x8 v; unsigned u[4]; } pb;
    pb.u[0] = pack2(s[2 * kk][0], s[2 * kk][1]); pb.u[1] = pack2(s[2 * kk][2], s[2 * kk][3]);
    pb.u[2] = pack2(s[2 * kk + 1][0], s[2 * kk + 1][1]); pb.u[3] = pack2(s[2 * kk + 1][2], s[2 * kk + 1][3]);
#pragma unroll
    for (int mt = 0; mt < 4; mt++) O[mt] = __builtin_amdgcn_mfma_f32_16x16x32_bf16(va[kk][mt], pb.v, O[mt], 0, 0, 0);
  }
}

struct TileRegs { u32x4 k0, k1, v0, v1; };
__device__ __forceinline__ void issue_tile(const u16* Kb, const u16* Vb, int vstride, int j, int tid, TileRegs& R) {
  int r = tid >> 3, ch = tid & 7;
  R.k0 = *(const u32x4*)(Kb + ((size_t)(j * 64 + r)) * 64 + ch * 8);
  R.k1 = *(const u32x4*)(Kb + ((size_t)(j * 64 + r + 32)) * 64 + ch * 8);
  R.v0 = *(const u32x4*)(Vb + (size_t)r * vstride + j * 64 + ch * 8);
  R.v1 = *(const u32x4*)(Vb + (size_t)(r + 32) * vstride + j * 64 + ch * 8);
  __builtin_amdgcn_sched_barrier(0);
}
#define TBUF 16384
__device__ __forceinline__ void write_tile(char* L, int tid, const TileRegs& R) {
  int r = tid >> 3, ch = tid & 7;
  int ko = r * 128 + ((ch ^ ((r >> 1) & 7)) << 4);
  *(u32x4*)(L + ko) = R.k0;
  *(u32x4*)(L + ko + 4096) = R.k1;
  *(u32x4*)(L + 8192 + ko) = R.v0;
  *(u32x4*)(L + 8192 + ko + 4096) = R.v1;
}
__device__ __forceinline__ int pop_bit(u64& um) {
  if (!um) return -1;
  int j = __builtin_ctzll(um);
  um &= um - 1;
  return j;
}

template <int MODE>
__device__ __forceinline__ void flash_branch(u64 um, const u16* Kb, const u16* Vb, int vstride, u64 mymask, const bf16x8 (&qf)[2],
                                             f32x4 (&O)[4], float& l, int t, int t0, float slope, char* L) {
  int tid = otid(), lane = tid & 63;
  TileRegs A, B;
  f32x4 dummy[4];
  um = ((u64)(unsigned)__builtin_amdgcn_readfirstlane((int)(unsigned)(um >> 32)) << 32) | (u64)(unsigned)__builtin_amdgcn_readfirstlane((int)(unsigned)um);
  int j0 = pop_bit(um), j1 = pop_bit(um), j2 = pop_bit(um);
  if (j0 < 0) return;
  const int jd = j0;
  issue_tile(Kb, Vb, vstride, j0, tid, A);
  issue_tile(Kb, Vb, vstride, j1 >= 0 ? j1 : jd, tid, B);
  __syncthreads();
  write_tile(L, tid, A);
  issue_tile(Kb, Vb, vstride, j2 >= 0 ? j2 : jd, tid, A);
  __syncthreads();
  while (true) {
    int j3 = pop_bit(um);
    write_tile(L + TBUF, tid, B);
    issue_tile(Kb, Vb, vstride, j3 >= 0 ? j3 : jd, tid, B);
    {
      bool rowsel = (MODE == 0) ? (((mymask >> j0) & 1ull) != 0) : true;
      if (__any(rowsel)) flash_tile<MODE>(L, L + 8192, qf, O, l, j0, t, t0, slope, rowsel, lane, dummy);
    }
    __syncthreads();
    if (j1 < 0) break;
    int j4 = pop_bit(um);
    write_tile(L, tid, A);
    issue_tile(Kb, Vb, vstride, j4 >= 0 ? j4 : jd, tid, A);
    {
      bool rowsel = (MODE == 0) ? (((mymask >> j1) & 1ull) != 0) : true;
      if (__any(rowsel)) flash_tile<MODE>(L + TBUF, L + TBUF + 8192, qf, O, l, j1, t, t0, slope, rowsel, lane, dummy);
    }
    __syncthreads();
    if (j2 < 0) break;
    j0 = j2; j1 = j3; j2 = j4;
  }
}

__device__ __forceinline__ void attn_hk(const Params& p, int idx, char* smem, const int hk, f32x4 (&OTh)[4]) {
  int tid = otid(), lane = tid & 63, wave = tid >> 6;
  int l15 = lane & 15, lq = lane >> 4;
  int b = idx >> 8, tq = 255 - (idx & 255);
  int t0 = tq * 16;
  int tl = wave * 4 + (l15 >> 2), gq = l15 & 3;
  int t = t0 + tl;
  int tok = b * SEQ + t;
  int cur = t0 >> 6;
  char* L = smem;
  float* imp = (float*)(smem + 32768);
  u64* selm = (u64*)(smem + 36864);
  int h = hk * 4 + gq;
  float slope = exp2f(-(float)(h + 1)) * 1.4426950408889634f;
  bf16x8 qf[2];
  qf[0] = *(const bf16x8*)(((u16*)(p.ws + OFF_Q)) + (size_t)tok * 512 + h * 64 + lq * 8);
  qf[1] = *(const bf16x8*)(((u16*)(p.ws + OFF_Q)) + (size_t)tok * 512 + h * 64 + 32 + lq * 8);
  const float* gsp = ((float*)(p.ws + OFF_GS)) + (size_t)tok * 24 + h;
  float g0 = gsp[0], g1 = gsp[8], g2 = gsp[16];
  int bh = b * 2 + hk;
  f32x4 Oacc[4];
#pragma unroll
  for (int mt = 0; mt < 4; mt++) Oacc[mt] = (f32x4){0.f, 0.f, 0.f, 0.f};
  int ntc = 0;
  if (t0 + 15 >= 31) ntc = (((t0 + 15 - 31) >> 4) >> 6) + 1;
  f32x4 sc[4][4];
#pragma unroll
  for (int kt = 0; kt < 4; kt++)
#pragma unroll
    for (int mt = 0; mt < 4; mt++) sc[kt][mt] = (f32x4){-1e30f, -1e30f, -1e30f, -1e30f};
  float lc = 0.f;
  if (ntc > 0) {
    const u16* Kb = ((u16*)(p.ws + OFF_KCN)) + (size_t)bh * 256 * 64;
    const u16* Vb = ((u16*)(p.ws + OFF_VCT)) + (size_t)bh * 64 * 256;
    TileRegs A, B;
    issue_tile(Kb, Vb, 256, 0, tid, A);
    issue_tile(Kb, Vb, 256, 1, tid, B);
    __syncthreads();
    write_tile(L, tid, A);
    issue_tile(Kb, Vb, 256, 2, tid, A);
    __syncthreads();
    write_tile(L + TBUF, tid, B);
    issue_tile(Kb, Vb, 256, 3, tid, B);
    flash_tile<2>(L, L + 8192, qf, Oacc, lc, 0, t, t0, slope, true, lane, sc[0]);
    __syncthreads();
    if (ntc > 1) {
      write_tile(L, tid, A);
      flash_tile<2>(L + TBUF, L + TBUF + 8192, qf, Oacc, lc, 1, t, t0, slope, true, lane, sc[1]);
      __syncthreads();
    }
    if (ntc > 2) {
      write_tile(L + TBUF, tid, B);
      flash_tile<2>(L, L + 8192, qf, Oacc, lc, 2, t, t0, slope, true, lane, sc[2]);
      __syncthreads();
    }
    if (ntc > 3) {
      flash_tile<2>(L + TBUF, L + TBUF + 8192, qf, Oacc, lc, 3, t, t0, slope, true, lane, sc[3]);
      __syncthreads();
    }
  }
  lc += __shfl_xor(lc, 16);
  lc += __shfl_xor(lc, 32);
  float linv = lc > 0.f ? 1.f / lc : 0.f;
  {
    float sc0 = g0 * linv;
#pragma unroll
    for (int mt = 0; mt < 4; mt++) { OTh[mt][0] = sc0 * Oacc[mt][0]; OTh[mt][1] = sc0 * Oacc[mt][1]; OTh[mt][2] = sc0 * Oacc[mt][2]; OTh[mt][3] = sc0 * Oacc[mt][3]; }
  }
  if (cur >= 16) {
    int srcl = (lane + 48) & 63;
    float p3prev = 0.f;
    int Tmax = cur >> 2;
#pragma unroll
    for (int T = 0; T < 16; T++) {
      if (T <= Tmax) {
      int kt = T >> 2, mt = T & 3;
      float p0 = __builtin_amdgcn_exp2f(sc[kt][mt][0]) * linv;
      float p1 = __builtin_amdgcn_exp2f(sc[kt][mt][1]) * linv;
      float p2 = __builtin_amdgcn_exp2f(sc[kt][mt][2]) * linv;
      float p3 = __builtin_amdgcn_exp2f(sc[kt][mt][3]) * linv;
      float Av = 2.f * (p0 + p1 + p2) + p3;
      float B3 = p3;
      Av += dpp_xor1(Av); Av += dpp_xor2(Av);
      B3 += dpp_xor1(B3); B3 += dpp_xor2(B3);
      float s1 = __shfl(B3, srcl);
      float prev = lq > 0 ? s1 : p3prev;
      p3prev = s1;
      if (gq == 0) {
        int jb = T * 4 + lq;
        unsigned key = (__float_as_uint(Av + prev) & ~63u) | (unsigned)(63 - jb);
        ((unsigned*)imp)[tl * 64 + jb] = (jb >= 1 && jb <= cur - 2) ? key : 0u;
      }
      }
    }
  }
  __syncthreads();
  {
    int nforced = cur == 0 ? 1 : (cur == 1 ? 2 : 3);
    int kk = 16 - nforced;
#pragma unroll 1
    for (int t4 = 0; t4 < 4; t4++) {
      int tt = wave * 4 + t4;
      int jb = lane;
      bool cand = (jb >= 1) && (jb <= cur - 2);
      bool forced = (jb == 0) || (jb == cur) || (jb == cur - 1);
      int rank = 0;
      if (cur >= 16) {
        const unsigned* kp = ((const unsigned*)imp) + tt * 64;
        unsigned myk = kp[jb];
        int n4 = ((cur - 2) >> 2) + 1;
#pragma unroll 4
        for (int i4 = 0; i4 < n4; i4++) {
          u32x4 kv = *(const u32x4*)(kp + i4 * 4);
          rank += (kv.x > myk) ? 1 : 0; rank += (kv.y > myk) ? 1 : 0; rank += (kv.z > myk) ? 1 : 0; rank += (kv.w > myk) ? 1 : 0;
        }
      }
      bool sel = forced || (cand && rank < kk);
      u64 mk = __ballot(sel);
      if (lane == 0) selm[tt] = mk;
    }
  }
  __syncthreads();
  {
    u64 mymask = selm[tl];
    u64 um = 0;
#pragma unroll
    for (int i = 0; i < 16; i++) um |= selm[i];
    um &= (cur >= 63) ? ~0ull : ((1ull << (cur + 1)) - 1ull);
    float l = 0.f;
#pragma unroll
    for (int mt = 0; mt < 4; mt++) Oacc[mt] = (f32x4){0.f, 0.f, 0.f, 0.f};
    flash_branch<0>(um, ((u16*)(p.ws + OFF_KS)) + (size_t)bh * SEQ * 64, ((u16*)(p.ws + OFF_VST)) + (size_t)bh * 64 * SEQ, SEQ, mymask, qf, Oacc, l, t, t0, slope, L);
    l += __shfl_xor(l, 16); l += __shfl_xor(l, 32);
    float sc1 = l > 0.f ? g1 / l : 0.f;
#pragma unroll
    for (int mt = 0; mt < 4; mt++) { OTh[mt][0] += sc1 * Oacc[mt][0]; OTh[mt][1] += sc1 * Oacc[mt][1]; OTh[mt][2] += sc1 * Oacc[mt][2]; OTh[mt][3] += sc1 * Oacc[mt][3]; }
  }
  {
    int lo = t0 - 511;
    int jlo = lo > 0 ? (lo >> 6) : 0;
    u64 wm_ = ((cur >= 63) ? ~0ull : ((1ull << (cur + 1)) - 1ull)) & ~((1ull << jlo) - 1ull);
    float l = 0.f;
#pragma unroll
    for (int mt = 0; mt < 4; mt++) Oacc[mt] = (f32x4){0.f, 0.f, 0.f, 0.f};
    flash_branch<1>(wm_, ((u16*)(p.ws + OFF_KW)) + (size_t)bh * SEQ * 64, ((u16*)(p.ws + OFF_VWT)) + (size_t)bh * 64 * SEQ, SEQ, 0ull, qf, Oacc, l, t, t0, slope, L);
    l += __shfl_xor(l, 16); l += __shfl_xor(l, 32);
    float sc2 = l > 0.f ? g2 / l : 0.f;
#pragma unroll
    for (int mt = 0; mt < 4; mt++) { OTh[mt][0] += sc2 * Oacc[mt][0]; OTh[mt][1] += sc2 * Oacc[mt][1]; OTh[mt][2] += sc2 * Oacc[mt][2]; OTh[mt][3] += sc2 * Oacc[mt][3]; }
  }
}

__device__ __forceinline__ void attn_tile(const Params& p, int idx, char* smem) {
  int tid = otid(), lane = tid & 63, wave = tid >> 6;
  int l15 = lane & 15, lq = lane >> 4;
  int b = idx >> 8, tq = 255 - (idx & 255);
  int t0 = tq * 16;
  int tl = wave * 4 + (l15 >> 2), gq = l15 & 3;
  int t = t0 + tl;
  int tok = b * SEQ + t;
  int cur = t0 >> 6;
  char* Kl = smem;
  char* Vl = smem + 8192;
  float* imp = (float*)(smem + 17408);
  u64* selm = (u64*)(smem + 21504);
  u32x2 zpre[2][4];
#pragma unroll
  for (int hk = 0; hk < 2; hk++)
#pragma unroll
    for (int mt = 0; mt < 4; mt++)
      zpre[hk][mt] = __builtin_nontemporal_load((const u32x2*)(((u16*)(p.ws + OFF_ZN)) + (size_t)tok * 512 + (hk * 4 + gq) * 64 + mt * 16 + lq * 4));
  f32x4 OT0[4], OT1[4];
  f32x4* park = (f32x4*)(smem + 40960);
#pragma unroll 1
  for (int hk = 0; hk < 2; hk++) {
    attn_hk(p, idx, smem, hk, OT1);
    if (hk == 0) {
#pragma unroll
      for (int mt = 0; mt < 4; mt++) park[mt * 256 + tid] = OT1[mt];
    }
  }
#pragma unroll
  for (int mt = 0; mt < 4; mt++) OT0[mt] = park[mt * 256 + tid];
  float ss = 0.f;
#pragma unroll
  for (int mt = 0; mt < 4; mt++)
#pragma unroll
    for (int r = 0; r < 4; r++) ss += OT0[mt][r] * OT0[mt][r] + OT1[mt][r] * OT1[mt][r];
  ss += dpp_xor1(ss); ss += dpp_xor2(ss); ss += __shfl_xor(ss, 16); ss += __shfl_xor(ss, 32);
  float rstd = rsqrtf(ss * (1.f / 512.f) + EPSF);
#pragma unroll
  for (int hk = 0; hk < 2; hk++)
#pragma unroll
    for (int mt = 0; mt < 4; mt++) {
      f32x4 ov = hk ? OT1[mt] : OT0[mt];
      int col = (hk * 4 + gq) * 64 + mt * 16 + lq * 4;
      f32x4 gg = *(const f32x4*)(p.g_on + col);
      u32x2 zz = zpre[hk][mt];
      float z0 = __uint_as_float(zz.x << 16), z1 = __uint_as_float(zz.x & 0xffff0000u);
      float z2 = __uint_as_float(zz.y << 16), z3 = __uint_as_float(zz.y & 0xffff0000u);
      u32x2 o;
      o.x = pack2(ov[0] * rstd * gg.x * siluf(z0), ov[1] * rstd * gg.y * siluf(z1));
      o.y = pack2(ov[2] * rstd * gg.z * siluf(z2), ov[3] * rstd * gg.w * siluf(z3));
      *(u32x2*)(((u16*)(p.ws + OFF_Y)) + (size_t)tok * 1024 + 512 + col) = o;
    }
}

__device__ __forceinline__ void lru_final_tile(const Params& p, int idx, char* smem) {
  int tid = otid(), lane = tid & 63, wave = tid >> 6;
  int c = idx & 63, b = idx >> 6;
  const float* cin = ((const float*)(p.ws + OFF_CIN)) + ((size_t)(b * 64 + c)) * 512;
  float cr[8], gg[8];
#pragma unroll
  for (int e = 0; e < 8; e++) { cr[e] = cin[lane * 8 + e]; gg[e] = p.g_ol[lane * 8 + e]; }
  for (int i = 0; i < 16; i++) {
    int tok = b * SEQ + c * 64 + wave * 16 + i;
    u32x4 hv = __builtin_nontemporal_load((const u32x4*)(((u16*)(p.ws + OFF_HL)) + (size_t)tok * 512 + lane * 8));
    u32x4 cv = __builtin_nontemporal_load((const u32x4*)(((u16*)(p.ws + OFF_CA)) + (size_t)tok * 512 + lane * 8));
    u32x4 zv = __builtin_nontemporal_load((const u32x4*)(((u16*)(p.ws + OFF_XZ)) + (size_t)tok * 1024 + 512 + lane * 8));
    float hf[8], cf[8], zf[8];
    unpack8(hv, hf); unpack8(cv, cf); unpack8(zv, zf);
    float ss = 0.f;
#pragma unroll
    for (int e = 0; e < 8; e++) { hf[e] = hf[e] + cf[e] * cr[e]; ss += hf[e] * hf[e]; }
    { ss += dpp_xor1(ss); ss += dpp_xor2(ss); ss += dpp_ror4(ss); ss += dpp_ror8(ss); ss += __shfl_xor(ss, 16); ss += __shfl_xor(ss, 32); }
    float rstd = rsqrtf(ss * (1.f / 512.f) + EPSF);
    float y[8];
#pragma unroll
    for (int e = 0; e < 8; e++) y[e] = hf[e] * rstd * gg[e] * siluf(zf[e]);
    u32x4 o; o.x = pack2(y[0], y[1]); o.y = pack2(y[2], y[3]); o.z = pack2(y[4], y[5]); o.w = pack2(y[6], y[7]);
    *(u32x4*)(((u16*)(p.ws + OFF_Y)) + (size_t)tok * 1024 + lane * 8) = o;
  }
}

__device__ __forceinline__ void phase4(const Params& p, char* smem) {
  for (int tile = blockIdx.x; tile < 2048 + 512; tile += gridDim.x) {
    if (tile < 2048) attn_tile(p, ((tile & 7) << 8) | (tile >> 3), smem);
    else lru_final_tile(p, tile - 2048, smem);
  }
}

__device__ __forceinline__ void gemm_out_tile(const Params& p, int tm, int tn, char* smem) {
  int tid = otid(), lane = tid & 63, wave = tid >> 6, wm = wave >> 1, wn = wave & 1;
  GemmArgs g;
  g.A = ((u16*)(p.ws + OFF_Y)) + (size_t)tm * 128 * 1024; g.a_rs = 1024; g.a_ks = 64;
  g.B = ((u16*)(p.ws + OFF_woutT)) + (size_t)tn * 128 * 1024; g.b_rs = 1024; g.nk = 16;
  int tok0 = tm * 128, b = tok0 >> 12;
  int c4 = tid & 31, r0 = tid >> 5;
  int col = tn * 128 + c4 * 4;
  f32x4 gt = *(const f32x4*)(((float*)(p.ws + OFF_MODZ)) + b * 3072 + 2048 + col);
  f32x4 xa[8], xb[8];
#pragma unroll
  for (int ps = 0; ps < 8; ps++) xa[ps] = __builtin_nontemporal_load((const f32x4*)(p.x + (size_t)(tok0 + r0 + ps * 8) * 1024 + col));
  f32x16 acc[2][2];
  gemm_main(g, smem, acc);
  int l31 = lane & 31, lh = lane >> 5;
  float* Cf = (float*)smem;
#pragma unroll
  for (int mt = 0; mt < 2; mt++)
#pragma unroll
    for (int nt = 0; nt < 2; nt++)
#pragma unroll
      for (int e = 0; e < 16; e++)
        Cf[(wm * 64 + mt * 32 + CROW(e, lh)) * 128 + wn * 64 + nt * 32 + l31] = acc[mt][nt][e];
#pragma unroll
  for (int ps = 0; ps < 8; ps++) xb[ps] = __builtin_nontemporal_load((const f32x4*)(p.x + (size_t)(tok0 + r0 + (8 + ps) * 8) * 1024 + col));
  __syncthreads();
#pragma unroll
  for (int ps = 0; ps < 8; ps++) {
    int r = r0 + ps * 8;
    f32x4 v = *(const f32x4*)(Cf + r * 128 + c4 * 4);
    f32x4 o = xa[ps] + gt * v;
    __builtin_nontemporal_store(o, (f32x4*)(p.out + (size_t)(tok0 + r) * 1024 + col));
  }
#pragma unroll
  for (int ps = 0; ps < 8; ps++) {
    int r = r0 + (8 + ps) * 8;
    f32x4 v = *(const f32x4*)(Cf + r * 128 + c4 * 4);
    f32x4 o = xb[ps] + gt * v;
    __builtin_nontemporal_store(o, (f32x4*)(p.out + (size_t)(tok0 + r) * 1024 + col));
  }
  __syncthreads();
}
__device__ __forceinline__ void phase5(const Params& p, char* smem) {
  int xcd = blockIdx.x & 7, loc = blockIdx.x >> 3, nloc = gridDim.x >> 3;
  for (int v = loc; v < 4 * 64; v += nloc) {
    int st = (v >> 6) * 8 + xcd, w = v & 63;
    gemm_out_tile(p, st * 8 + (w >> 3), w & 7, smem);
  }
}

template <int PH>
__global__ void __launch_bounds__(256, LB_MIN) phase_kernel(Params p) {
  __shared__ __attribute__((aligned(16))) char smem[65536];
  if (PH == 0) phase0(p, smem);
  if (PH == 1) phase1(p, smem);
  if (PH == 2) phase2(p, smem);
  if (PH == 3) phase3(p, smem, 0);
  if (PH == 4) phase4(p, smem);
  if (PH == 5) phase5(p, smem);
  if (PH == 6) phase3b(p, smem);
}

#define XB_TMO      128
#define XB_XCNT(j)  (256  + 64 * (j))
#define XB_XSUB(j)  (1280 + 64 * (j))
#define XB_XGEN(j)  (2304 + 64 * (j))
#define XB_TOP      3328
#define XB_TOPGEN   3392
#define XCD_BAR_WORDS 3456
#define XB_SPIN_CAP (1u << 20)
__device__ __forceinline__ unsigned xb_ld(unsigned* p) { return __hip_atomic_load(p, __ATOMIC_RELAXED, __HIP_MEMORY_SCOPE_AGENT); }
__device__ __forceinline__ unsigned xb_add(unsigned* p, unsigned v) { return __hip_atomic_fetch_add(p, v, __ATOMIC_RELAXED, __HIP_MEMORY_SCOPE_AGENT); }
__device__ __forceinline__ unsigned xb_xcc_id() { return (unsigned)__builtin_amdgcn_s_getreg((3 << 11) | 20) & 0xFu; }
#define XB_SPIN(cond, bar) do { unsigned _sp = 0; while (cond) { __builtin_amdgcn_s_sleep(1); \
    if ((++_sp & 255u) == 0u) { if (xb_ld(&(bar)[XB_TMO])) break; if (_sp > XB_SPIN_CAP) { atomicAdd(&(bar)[XB_TMO], 1u); break; } } } } while (0)
struct XcdBarrier { unsigned* bar; unsigned x; unsigned nloc; unsigned nx; };
__device__ __forceinline__ void xcd_barrier_complete(unsigned* bar, unsigned x, unsigned& nloc, unsigned& nx) {
  const unsigned G = gridDim.x;
  unsigned sum, cnt, mine, sp = 0u;
  for (;;) {
    sum = 0u; cnt = 0u; mine = 0u;
#pragma unroll
    for (unsigned j = 0; j < 16; ++j) { const unsigned c = xb_ld(&bar[XB_XCNT(j)]); sum += c; cnt += (c > 0u) ? 1u : 0u; mine = (j == x) ? c : mine; }
    if (sum == G) break;
    __builtin_amdgcn_s_sleep(1);
    if ((++sp & 255u) == 0u) { if (xb_ld(&bar[XB_TMO])) break; if (sp > XB_SPIN_CAP) { atomicAdd(&bar[XB_TMO], 1u); break; } }
  }
  nloc = mine > 0u ? mine : 1u; nx = cnt > 0u ? cnt : 1u;
}
__device__ __forceinline__ void xcd_barrier(XcdBarrier& b) {
  asm volatile("s_waitcnt vmcnt(0)" ::: "memory");
  __syncthreads();
  if (threadIdx.x == 0) {
    unsigned* bar = b.bar;
    __builtin_amdgcn_s_waitcnt(0);
    unsigned nloc = b.nloc, nx = b.nx;
    if (nloc == 0u) { xcd_barrier_complete(bar, b.x, nloc, nx); b.nloc = nloc; b.nx = nx; }
    const unsigned old = xb_add(&bar[XB_XSUB(b.x)], 1u);
    const unsigned gen = old / nloc;
    if (old + 1u == (gen + 1u) * nloc) {
      __builtin_amdgcn_fence(__ATOMIC_RELEASE, "agent");
      asm volatile("s_waitcnt vmcnt(0)" ::: "memory");
      const unsigned og = xb_add(&bar[XB_TOP], 1u);
      const unsigned tg = og / nx;
      if (og + 1u == (tg + 1u) * nx) xb_add(&bar[XB_TOPGEN], 1u);
      else XB_SPIN(xb_ld(&bar[XB_TOPGEN]) == tg, bar);
      __builtin_amdgcn_fence(__ATOMIC_ACQUIRE, "agent");
      xb_add(&bar[XB_XGEN(b.x)], 1u);
      asm volatile("s_waitcnt vmcnt(0)" ::: "memory");
    } else {
      XB_SPIN(xb_ld(&bar[XB_XGEN(b.x)]) == gen, bar);
      __builtin_amdgcn_fence(__ATOMIC_ACQUIRE, "agent");
      asm volatile("s_waitcnt vmcnt(0)" ::: "memory");
    }
  }
  __syncthreads();
}

__global__ void __launch_bounds__(256, LB_MIN) fused_kernel(Params p) {
  __shared__ __attribute__((aligned(16))) char smem[65536];
  unsigned* bar = (unsigned*)(p.ws + OFF_BAR);
  XcdBarrier xb; xb.bar = bar; xb.x = xb_xcc_id(); xb.nloc = 0u; xb.nx = 0u;
  if (threadIdx.x == 0) (void)xb_add(&bar[XB_XCNT(xb.x)], 1u);
  phase0(p, smem); xcd_barrier(xb);
#if PROBE_PH == 1
  phase1(p, smem); xcd_barrier(xb);
#endif
  phase1(p, smem); xcd_barrier(xb);
#if PROBE_PH == 2
  phase2(p, smem); xcd_barrier(xb);
#endif
  phase2(p, smem); xcd_barrier(xb);
#if PROBE_PH == 3
  phase3(p, smem, 128); xcd_barrier(xb);
#endif
  phase3(p, smem, 0); xcd_barrier(xb);
  phase3b(p, smem); xcd_barrier(xb);
#if PROBE_PH == 4
  phase4(p, smem); xcd_barrier(xb);
#endif
  phase4(p, smem); xcd_barrier(xb);
#if PROBE_PH == 5
  phase5(p, smem); xcd_barrier(xb);
#endif
  phase5(p, smem);
}

extern "C" void kernel_launch(void* const* d_in, const int* in_sizes, int n_in, void* d_out, int out_size, void* d_ws,
                              size_t ws_size, hipStream_t stream) {
  Params p{};
  const float* const* in = (const float* const*)d_in;
  p.x = in[0]; p.c = in[1]; p.w_ada = in[2]; p.b_ada = in[3]; p.norm_g = in[4]; p.w_in = in[5]; p.conv_w = in[6]; p.conv_b = in[7];
  p.w_rg_a = in[8]; p.b_rg_a = in[9]; p.w_rg_x = in[10]; p.b_rg_x = in[11]; p.lam = in[12];
  p.pos_k = in[13]; p.w1_k = in[14]; p.w2_k = in[15]; p.pos_v = in[16]; p.w1_v = in[17]; p.w2_v = in[18];
  p.g_q = in[19]; p.g_kc = in[20]; p.g_ks = in[21]; p.g_kw = in[22]; p.g_ol = in[23]; p.g_on = in[24]; p.w_out = in[25];
  p.out = (float*)d_out;
  p.ws = (char*)d_ws;
  (void)ws_size; (void)in_sizes; (void)n_in; (void)out_size;
#if FUSED
  static int grid_blocks = 0;
  if (!grid_blocks) {
    int dev = 0, cus = 0, per_cu = 0;
    hipGetDevice(&dev);
    hipDeviceGetAttribute(&cus, hipDeviceAttributeMultiprocessorCount, dev);
    hipOccupancyMaxActiveBlocksPerMultiprocessor(&per_cu, fused_kernel, 256, 0);
    if (per_cu > 2) per_cu = 2;
    grid_blocks = cus * per_cu;
  }
  void* args[] = {&p};
  (void)hipMemsetAsync(p.ws + OFF_BAR, 0, 16384 + 8 * 3072 * 4, stream);
  hipError_t e = hipLaunchCooperativeKernel((void*)fused_kernel, dim3(grid_blocks), dim3(256), args, 0, stream);
  if (e != hipSuccess) fprintf(stderr, "cooperative launch failed: %s (grid %d)\n", hipGetErrorString(e), grid_blocks);
#else
  const int G = 1024;
  phase_kernel<0><<<G, 256, 0, stream>>>(p);
  phase_kernel<1><<<G, 256, 0, stream>>>(p);
  phase_kernel<2><<<G, 256, 0, stream>>>(p);
  phase_kernel<3><<<G, 256, 0, stream>>>(p);
  phase_kernel<6><<<G, 256, 0, stream>>>(p);
  phase_kernel<4><<<G, 256, 0, stream>>>(p);
  phase_kernel<5><<<G, 256, 0, stream>>>(p);
#endif
}
```

```cpp
#include <hip/hip_runtime.h>
#include <hip/hip_bf16.h>
#include <hip/hip_cooperative_groups.h>
#include <cstdio>
namespace cg = cooperative_groups;

#ifndef FUSED
#define FUSED 1
#endif

typedef __attribute__((ext_vector_type(8))) short bf16x8;
typedef __attribute__((ext_vector_type(4))) float f32x4;
typedef __attribute__((ext_vector_type(16))) float f32x16;
typedef __attribute__((ext_vector_type(4))) unsigned u32x4;
typedef __attribute__((ext_vector_type(2))) unsigned u32x2;
typedef unsigned short u16;
typedef unsigned long long u64;

#ifndef PROBE_PH
#define PROBE_PH 0
#endif
#ifndef LB_MIN
#define LB_MIN 2
#endif
#define NTOK 32768
#define SEQ 4096
#define NP 2944
#define EPSF 1e-6f

struct Params {
  const float *x, *c, *w_ada, *b_ada, *norm_g, *w_in, *conv_w, *conv_b, *w_rg_a, *b_rg_a, *w_rg_x, *b_rg_x, *lam;
  const float *pos_k, *w1_k, *w2_k, *pos_v, *w1_v, *w2_v, *g_q, *g_kc, *g_ks, *g_kw, *g_ol, *g_on, *w_out;
  float* out;
  char* ws;
};
#define OFF_mod 0ull
#define OFF_winT 98304ull
#define OFF_woutT 6127616ull
#define OFF_w1T0 8224768ull
#define OFF_w1T1 9273344ull
#define OFF_w2T0 10321920ull
#define OFF_w2T1 10354688ull
#define OFF_waT 10387456ull
#define OFF_wxT 10452992ull
#define OFF_bias1 10518528ull
#define OFF_H 10520576ull
#define OFF_XZ 77629440ull
#define OFF_Q 144738304ull
#define OFF_KVC 178292736ull
#define OFF_KS 195102720ull
#define OFF_KW 203491328ull
#define OFF_VST 211879936ull
#define OFF_VWT 220268544ull
#define OFF_ZN 228657152ull
#define OFF_GS 262211584ull
#define OFF_CACC 265357312ull
#define OFF_HL 267454464ull
#define OFF_CA 301008896ull
#define OFF_CE 334563328ull
#define OFF_Y OFF_H
#define OFF_KCN (WS_TOTAL + 256ull)
#define OFF_VCT (OFF_KCN + 16ull * 256 * 64 * 2)
#define OFF_CIN (OFF_VCT + 16ull * 64 * 256 * 2)
#define OFF_BAR (OFF_CIN + 8ull * 64 * 512 * 4)
#define OFF_B1S (OFF_BAR + 16384ull + 98304ull)
#define OFF_MODZ (OFF_BAR + 16384ull)
#define WS_TOTAL 336660480ull

typedef __attribute__((ext_vector_type(2))) __bf16 bf2_t;
typedef __attribute__((ext_vector_type(2))) float f2_t;
__device__ __forceinline__ unsigned pack2(float a, float b) {
  f2_t v = {a, b};
  bf2_t r = __builtin_convertvector(v, bf2_t);
  return *(unsigned*)&r;
}
__device__ __forceinline__ u16 f2bf(float f) { return (u16)(pack2(f, 0.f) & 0xffffu); }
__device__ __forceinline__ float dpp_xor1(float v) { return __int_as_float(__builtin_amdgcn_update_dpp(0, __float_as_int(v), 0xB1, 0xF, 0xF, true)); }
__device__ __forceinline__ float dpp_xor2(float v) { return __int_as_float(__builtin_amdgcn_update_dpp(0, __float_as_int(v), 0x4E, 0xF, 0xF, true)); }
__device__ __forceinline__ float dpp_ror4(float v) { return __int_as_float(__builtin_amdgcn_update_dpp(0, __float_as_int(v), 0x124, 0xF, 0xF, true)); }
__device__ __forceinline__ float dpp_ror8(float v) { return __int_as_float(__builtin_amdgcn_update_dpp(0, __float_as_int(v), 0x128, 0xF, 0xF, true)); }
__device__ __forceinline__ int otid() { int t = threadIdx.x; asm volatile("" : "+v"(t)); return t; }
__device__ __forceinline__ float bf2f(u16 h) { return __uint_as_float(((unsigned)h) << 16); }
__device__ __forceinline__ float sigmoidf(float v) { return __builtin_amdgcn_rcpf(1.f + __expf(-v)); }
__device__ __forceinline__ float siluf(float v) { return v * __builtin_amdgcn_rcpf(1.f + __expf(-v)); }
__device__ __forceinline__ float gelu_tanh(float v) {
  float u = 0.7978845608028654f * (v + 0.044715f * v * v * v);
  return v * __builtin_amdgcn_rcpf(1.f + __expf(-2.f * u));
}
__device__ __forceinline__ void unpack8(u32x4 v, float* f) {
  f[0] = __uint_as_float(v.x << 16); f[1] = __uint_as_float(v.x & 0xffff0000u);
  f[2] = __uint_as_float(v.y << 16); f[3] = __uint_as_float(v.y & 0xffff0000u);
  f[4] = __uint_as_float(v.z << 16); f[5] = __uint_as_float(v.z & 0xffff0000u);
  f[6] = __uint_as_float(v.w << 16); f[7] = __uint_as_float(v.w & 0xffff0000u);
}

__device__ __forceinline__ void tr_tile(const float* __restrict__ src, int ld_src, int k0, int n0, u16* __restrict__ dst, int ld_dst,
                        int remap, float* lds) {
  int tid = threadIdx.x;
  int n = tid & 63, kq = tid >> 6;
  int np = n0 + n, sc = np; bool ok = true;
  if (remap) {
    if (np < 2304) sc = np; else if (np < 2816) sc = np + 24; else if (np < 2840) sc = np - 512; else ok = false;
  }
#pragma unroll
  for (int i = 0; i < 16; i++) {
    int k = i * 4 + kq;
    lds[k * 65 + n] = ok ? src[(size_t)(k0 + k) * ld_src + sc] : 0.f;
  }
  __syncthreads();
  int nn = tid >> 2, kk = (tid & 3) * 16;
  u32x4 o0, o1;
  o0.x = pack2(lds[(kk + 0) * 65 + nn], lds[(kk + 1) * 65 + nn]);
  o0.y = pack2(lds[(kk + 2) * 65 + nn], lds[(kk + 3) * 65 + nn]);
  o0.z = pack2(lds[(kk + 4) * 65 + nn], lds[(kk + 5) * 65 + nn]);
  o0.w = pack2(lds[(kk + 6) * 65 + nn], lds[(kk + 7) * 65 + nn]);
  o1.x = pack2(lds[(kk + 8) * 65 + nn], lds[(kk + 9) * 65 + nn]);
  o1.y = pack2(lds[(kk + 10) * 65 + nn], lds[(kk + 11) * 65 + nn]);
  o1.z = pack2(lds[(kk + 12) * 65 + nn], lds[(kk + 13) * 65 + nn]);
  o1.w = pack2(lds[(kk + 14) * 65 + nn], lds[(kk + 15) * 65 + nn]);
  u32x4* d = (u32x4*)(dst + (size_t)(n0 + nn) * ld_dst + k0 + kk);
  d[0] = o0; d[1] = o1;
  __syncthreads();
}

__device__ __forceinline__ void mod_tile(const Params& p, int tile, char* smem) {
  int tid = threadIdx.x;
  float* sc = (float*)smem;
  float* red = (float*)(smem + 8192);
  int ct = tile >> 2, kq = tile & 3;
  for (int i = tid; i < 2048; i += 256) { int b = i >> 8, k = i & 255; float cv = p.c[b * 1024 + kq * 256 + k]; sc[i] = siluf(cv); }
  __syncthreads();
  int col0 = ct * 32, col = tid & 31, ks = tid >> 5;
  float acc[8];
#pragma unroll
  for (int b = 0; b < 8; b++) acc[b] = 0.f;
  float w[32];
#pragma unroll
  for (int k = 0; k < 32; k++) w[k] = p.w_ada[(size_t)(kq * 256 + ks * 32 + k) * 3072 + col0 + col];
#pragma unroll
  for (int k = 0; k < 32; k++) {
#pragma unroll
    for (int b = 0; b < 8; b++) acc[b] += sc[b * 256 + ks * 32 + k] * w[k];
  }
#pragma unroll
  for (int b = 0; b < 8; b++) red[(ks * 8 + b) * 32 + col] = acc[b];
  __syncthreads();
  {
    int b = tid >> 5;
    float s = 0.f;
#pragma unroll
    for (int k2 = 0; k2 < 8; k2++) s += red[(k2 * 8 + b) * 32 + col];
    if (kq == 0) s += p.b_ada[col0 + col];
    atomicAdd(((float*)(p.ws + OFF_MODZ)) + b * 3072 + col0 + col, s);
  }
  __syncthreads();
}

__device__ __forceinline__ void bias1_tile(const Params& p, int i, char* smem) {
  int tid = threadIdx.x;
  int kv = i >> 5, cgp = (i >> 3) & 3, kq = i & 7;
  const float* pos = kv ? p.pos_v : p.pos_k;
  const float* w1 = kv ? p.w1_v : p.w1_k;
  float* red = (float*)smem;
  int col = cgp * 64 + (tid & 63), ks = tid >> 6;
  int kb = kq * 256 + ks * 64;
  float acc = 0.f;
#pragma unroll 1
  for (int k4 = 0; k4 < 4; k4++) {
    float w[16];
#pragma unroll
    for (int e = 0; e < 16; e++) w[e] = w1[(size_t)(kb + k4 * 16 + e) * 256 + col];
#pragma unroll
    for (int e = 0; e < 16; e++) acc += pos[kb + k4 * 16 + e] * w[e];
  }
  red[tid] = acc;
  __syncthreads();
  if (tid < 64) ((float*)(p.ws + OFF_B1S))[kq * 512 + kv * 256 + col] = (red[tid] + red[tid + 64]) + (red[tid + 128] + red[tid + 192]);
  __syncthreads();
}

__device__ __forceinline__ void phase0(const Params& p, char* smem) {
  float* lds = (float*)smem;
  for (int t = blockIdx.x; t < 1720; t += gridDim.x) {
    if (t < 384) mod_tile(p, t, smem);
    else if (t < 1120) { int i = t - 384; tr_tile(p.w_in, 2840, (i / 46) * 64, (i % 46) * 64, ((u16*)(p.ws + OFF_winT)), 1024, 1, lds); }
    else if (t < 1376) { int i = t - 1120; tr_tile(p.w_out, 1024, (i >> 4) * 64, (i & 15) * 64, ((u16*)(p.ws + OFF_woutT)), 1024, 0, lds); }
    else if (t < 1504) { int i = t - 1376; tr_tile(p.w1_k, 256, (i >> 2) * 64, (i & 3) * 64, ((u16*)(p.ws + OFF_w1T0)), 2048, 0, lds); }
    else if (t < 1632) { int i = t - 1504; tr_tile(p.w1_v, 256, (i >> 2) * 64, (i & 3) * 64, ((u16*)(p.ws + OFF_w1T1)), 2048, 0, lds); }
    else if (t < 1636) { int i = t - 1632; tr_tile(p.w2_k, 64, i * 64, 0, ((u16*)(p.ws + OFF_w2T0)), 256, 0, lds); }
    else if (t < 1640) { int i = t - 1636; tr_tile(p.w2_v, 64, i * 64, 0, ((u16*)(p.ws + OFF_w2T1)), 256, 0, lds); }
    else if (t < 1648) { int i = t - 1640; tr_tile(p.w_rg_a + i * 4096, 64, 0, 0, ((u16*)(p.ws + OFF_waT)) + i * 4096, 64, 0, lds); }
    else if (t < 1656) { int i = t - 1648; tr_tile(p.w_rg_x + i * 4096, 64, 0, 0, ((u16*)(p.ws + OFF_wxT)) + i * 4096, 64, 0, lds); }
    else bias1_tile(p, t - 1656, smem);
  }
  f32x4 z = {0.f, 0.f, 0.f, 0.f};
  for (int i = blockIdx.x * 256 + threadIdx.x; i < 131072; i += gridDim.x * 256) ((f32x4*)((float*)(p.ws + OFF_CACC)))[i] = z;
}

__device__ __forceinline__ void phase1(const Params& p, char* smem) {
  int lane = threadIdx.x & 63, wave = threadIdx.x >> 6;
  f32x4 v[4][4], nv[4][4];
  int tile = blockIdx.x;
  if (tile < 2048) {
#pragma unroll
    for (int tt = 0; tt < 4; tt++)
#pragma unroll
      for (int i = 0; i < 4; i++) v[tt][i] = __builtin_nontemporal_load((const f32x4*)(p.x + (size_t)(tile * 16 + wave * 4 + tt) * 1024 + i * 256 + lane * 4));
  }
  for (; tile < 2048; tile += gridDim.x) {
    int tokb = tile * 16 + wave * 4;
    int b = tokb >> 12;
    int ntile = tile + gridDim.x;
    if (ntile < 2048) {
#pragma unroll
      for (int tt = 0; tt < 4; tt++)
#pragma unroll
        for (int i = 0; i < 4; i++) nv[tt][i] = __builtin_nontemporal_load((const f32x4*)(p.x + (size_t)(ntile * 16 + wave * 4 + tt) * 1024 + i * 256 + lane * 4));
    }
    const float* md = ((float*)(p.ws + OFF_MODZ)) + b * 3072;
    f32x4 g[4], sh[4];
#pragma unroll
    for (int i = 0; i < 4; i++) {
      int k = i * 256 + lane * 4;
      g[i] = *(const f32x4*)(p.norm_g + k);
      sh[i] = *(const f32x4*)(md + k);
      f32x4 sc = *(const f32x4*)(md + 1024 + k);
      g[i] = g[i] * (1.f + sc);
    }
#pragma unroll
    for (int tt = 0; tt < 4; tt++) {
      float ss = 0.f;
#pragma unroll
      for (int i = 0; i < 4; i++) ss += v[tt][i].x * v[tt][i].x + v[tt][i].y * v[tt][i].y + v[tt][i].z * v[tt][i].z + v[tt][i].w * v[tt][i].w;
      { ss += dpp_xor1(ss); ss += dpp_xor2(ss); ss += dpp_ror4(ss); ss += dpp_ror8(ss); ss += __shfl_xor(ss, 16); ss += __shfl_xor(ss, 32); }
      float rstd = rsqrtf(ss * (1.f / 1024.f) + EPSF);
#pragma unroll
      for (int i = 0; i < 4; i++) {
        int k = i * 256 + lane * 4;
        f32x4 h = v[tt][i] * rstd * g[i] + sh[i];
        u32x2 o; o.x = pack2(h.x, h.y); o.y = pack2(h.z, h.w);
        *(u32x2*)(((u16*)(p.ws + OFF_H)) + (size_t)(tokb + tt) * 1024 + k) = o;
      }
    }
#pragma unroll
    for (int tt = 0; tt < 4; tt++)
#pragma unroll
      for (int i = 0; i < 4; i++) v[tt][i] = nv[tt][i];
  }
}

struct GemmArgs { const u16* A; size_t a_rs; size_t a_ks; const u16* B; size_t b_rs; int nk; };

__device__ __forceinline__ void glds16(const u16* g, char* l) {
  __builtin_amdgcn_global_load_lds((const unsigned*)g, (unsigned*)l, 16, 0, 0);
}
__device__ __forceinline__ void gemm_main(const GemmArgs& g, char* smem, f32x16 (&acc)[2][2]) {
  int tid = otid(), lane = tid & 63, wave = tid >> 6, wm = wave >> 1, wn = wave & 1;
  int r0 = tid >> 3, lch = (tid & 7) ^ ((tid >> 4) & 7);
  const u16* ap = g.A + (size_t)r0 * g.a_rs + lch * 8;
  const u16* bp = g.B + (size_t)r0 * g.b_rs + lch * 8;
  size_t astep = 32 * g.a_rs, bstep = 32 * g.b_rs;
  int so = tid * 16;
#pragma unroll
  for (int mt = 0; mt < 2; mt++)
#pragma unroll
    for (int nt = 0; nt < 2; nt++)
#pragma unroll
      for (int e = 0; e < 16; e++) acc[mt][nt][e] = 0.f;
#pragma unroll
  for (int i = 0; i < 4; i++) { glds16(ap + i * astep, smem + so + i * 4096); glds16(bp + i * bstep, smem + 16384 + so + i * 4096); }
  __syncthreads();
  int l31 = lane & 31, lh = lane >> 5;
  int sw = (l31 >> 1) & 7;
  int aoff = (wm * 64 + l31) * 128, boff = 16384 + (wn * 64 + l31) * 128;
  for (int kt = 0; kt < g.nk; kt++) {
    bool more = (kt + 1 < g.nk);
    if (more) {
      ap += g.a_ks; bp += 64;
      char* Wn = smem + ((kt + 1) & 1) * 32768;
#pragma unroll
      for (int i = 0; i < 4; i++) { glds16(ap + i * astep, Wn + so + i * 4096); glds16(bp + i * bstep, Wn + 16384 + so + i * 4096); }
    }
    __builtin_amdgcn_sched_barrier(0);
    const char* Ls = smem + (kt & 1) * 32768;
    {
      bf16x8 fa[2][2], fb[2][2];
      {
        int off = ((lh ^ sw) << 4);
#pragma unroll
        for (int mt = 0; mt < 2; mt++) fa[0][mt] = *(const bf16x8*)(Ls + aoff + mt * 4096 + off);
#pragma unroll
        for (int nt = 0; nt < 2; nt++) fb[0][nt] = *(const bf16x8*)(Ls + boff + nt * 4096 + off);
      }
#pragma unroll
      for (int ks = 0; ks < 4; ks++) {
        if (ks < 3) {
          int off = ((((ks + 1) * 2 + lh) ^ sw) << 4);
#pragma unroll
          for (int mt = 0; mt < 2; mt++) fa[(ks + 1) & 1][mt] = *(const bf16x8*)(Ls + aoff + mt * 4096 + off);
#pragma unroll
          for (int nt = 0; nt < 2; nt++) fb[(ks + 1) & 1][nt] = *(const bf16x8*)(Ls + boff + nt * 4096 + off);
        }
#pragma unroll
        for (int mt = 0; mt < 2; mt++)
#pragma unroll
          for (int nt = 0; nt < 2; nt++)
            acc[mt][nt] = __builtin_amdgcn_mfma_f32_32x32x16_bf16(fa[ks & 1][mt], fb[ks & 1][nt], acc[mt][nt], 0, 0, 0);
        __builtin_amdgcn_sched_barrier(0);
      }
    }
    __syncthreads();
  }
}

#define CROW(reg, lh) (((reg) & 3) + 8 * ((reg) >> 2) + 4 * (lh))
#define CLD 136

__device__ __forceinline__ void stage_c(char* smem, const f32x16 (&acc)[2][2], int wm, int wn, int lane) {
  u16* C = (u16*)smem;
  int l31 = lane & 31, lh = lane >> 5;
#pragma unroll
  for (int mt = 0; mt < 2; mt++)
#pragma unroll
    for (int nt = 0; nt < 2; nt++)
#pragma unroll
      for (int e = 0; e < 16; e++) {
        int row = wm * 64 + mt * 32 + CROW(e, lh);
        int col = wn * 64 + nt * 32 + l31;
        C[row * CLD + col] = f2bf(acc[mt][nt][e]);
      }
}

__device__ __forceinline__ void copy_rows(const char* smem, int hf, u16* dst, size_t ld) {
  const u16* C = (const u16*)smem;
  int tid = threadIdx.x, sub = tid & 7, r0 = tid >> 3;
#pragma unroll
  for (int ps = 0; ps < 4; ps++) {
    int r = r0 + ps * 32;
    u32x4 v = *(const u32x4*)(C + r * CLD + hf * 64 + sub * 8);
    *(u32x4*)(dst + (size_t)r * ld + sub * 8) = v;
  }
}
__device__ __forceinline__ void copy_transposed(const char* smem, int hf, u16* dst  ) {
  const u16* C = (const u16*)smem;
  int tid = threadIdx.x, d = tid >> 2, tq = tid & 3;
  unsigned w[16];
#pragma unroll
  for (int i = 0; i < 16; i++) {
    int pp = 2 * i;
    int ii = ((pp >> 2) & 1) * 16 + (pp >> 3) * 4 + (pp & 3);
    unsigned lo = C[(tq * 32 + ii) * CLD + hf * 64 + d];
    unsigned hi = C[(tq * 32 + ii + 1) * CLD + hf * 64 + d];
    w[i] = lo | (hi << 16);
  }
  u32x4* o = (u32x4*)(dst + (size_t)d * SEQ + tq * 32);
  u32x4 a = {w[0], w[1], w[2], w[3]}, b = {w[4], w[5], w[6], w[7]}, c = {w[8], w[9], w[10], w[11]}, e = {w[12], w[13], w[14], w[15]};
  o[0] = a; o[1] = b; o[2] = c; o[3] = e;
}

__device__ __forceinline__ void gemm_in_tile(const Params& p, int tm, int tn, char* smem) {
  int tid = otid(), lane = tid & 63, wave = tid >> 6, wm = wave >> 1, wn = wave & 1;
  GemmArgs g;
  g.A = ((u16*)(p.ws + OFF_H)) + (size_t)tm * 128 * 1024; g.a_rs = 1024; g.a_ks = 64;
  g.B = ((u16*)(p.ws + OFF_winT)) + (size_t)tn * 128 * 1024; g.b_rs = 1024; g.nk = 16;
  f32x16 acc[2][2];
  gemm_main(g, smem, acc);
  int tok0 = tm * 128, b = tok0 >> 12, t0 = tok0 & 4095;
  int cb = tn * 2 + wn;
  int l31 = lane & 31, lh = lane >> 5;
  const float* gam = nullptr; float qs = 1.f;
  if (cb >= 16 && cb < 24) { gam = p.g_q; qs = 0.125f * 1.4426950408889634f; }
  else if (cb == 28 || cb == 29) gam = p.g_ks;
  else if (cb == 32 || cb == 33) gam = p.g_kw;
  if (gam) {
    float g0 = gam[l31] * qs, g1 = gam[32 + l31] * qs;
#pragma unroll
    for (int mt = 0; mt < 2; mt++)
#pragma unroll
      for (int e = 0; e < 16; e++) {
        float v = acc[mt][0][e] * acc[mt][0][e] + acc[mt][1][e] * acc[mt][1][e];
        v += dpp_xor1(v); v += dpp_xor2(v); v += dpp_ror4(v); v += dpp_ror8(v); v += __shfl_xor(v, 16);
        float rstd = rsqrtf(v * (1.f / 64.f) + EPSF);
        acc[mt][0][e] *= rstd * g0; acc[mt][1][e] *= rstd * g1;
      }
  }
  if (cb == 44) {
    if (l31 < 24) {
#pragma unroll
      for (int mt = 0; mt < 2; mt++)
#pragma unroll
        for (int e = 0; e < 16; e++) {
          int row = wm * 64 + mt * 32 + CROW(e, lh);
          ((float*)(p.ws + OFF_GS))[(size_t)(tok0 + row) * 24 + l31] = sigmoidf(acc[mt][0][e]);
        }
    }
  }
  stage_c(smem, acc, wm, wn, lane);
  __syncthreads();
#pragma unroll 1
  for (int hf = 0; hf < 2; hf++) {
    int c2 = tn * 2 + hf;
    if (c2 < 16) copy_rows(smem, hf, ((u16*)(p.ws + OFF_XZ)) + (size_t)tok0 * 1024 + c2 * 64, 1024);
    else if (c2 < 24) copy_rows(smem, hf, ((u16*)(p.ws + OFF_Q)) + (size_t)tok0 * 512 + (c2 - 16) * 64, 512);
    else if (c2 < 28) copy_rows(smem, hf, ((u16*)(p.ws + OFF_KVC)) + (size_t)tok0 * 256 + (c2 - 24) * 64, 256);
    else if (c2 < 30) copy_rows(smem, hf, ((u16*)(p.ws + OFF_KS)) + ((size_t)(b * 2 + (c2 - 28)) * SEQ + t0) * 64, 64);
    else if (c2 < 32) copy_transposed(smem, hf, ((u16*)(p.ws + OFF_VST)) + (size_t)(b * 2 + (c2 - 30)) * 64 * SEQ + t0);
    else if (c2 < 34) copy_rows(smem, hf, ((u16*)(p.ws + OFF_KW)) + ((size_t)(b * 2 + (c2 - 32)) * SEQ + t0) * 64, 64);
    else if (c2 < 36) copy_transposed(smem, hf, ((u16*)(p.ws + OFF_VWT)) + (size_t)(b * 2 + (c2 - 34)) * 64 * SEQ + t0);
    else if (c2 < 44) copy_rows(smem, hf, ((u16*)(p.ws + OFF_ZN)) + (size_t)tok0 * 512 + (c2 - 36) * 64, 512);
  }
  __syncthreads();
}

__device__ __forceinline__ void phase2(const Params& p, char* smem) {
  int xcd = blockIdx.x & 7, loc = blockIdx.x >> 3, nloc = gridDim.x >> 3;
  for (int v = loc; v < 12 * 64; v += nloc) {
    int st = (v >> 6) * 8 + xcd, w = v & 63;
    int tm = (st / 3) * 8 + (w & 7), tn = (st % 3) * 8 + (w >> 3);
    if (tn < 23) gemm_in_tile(p, tm, tn, smem);
  }
}

__device__ __forceinline__ void compress_tile(const Params& p, int idx, char* smem) {
  int tid = otid(), lane = tid & 63, wave = tid >> 6, wm = wave >> 1, wn = wave & 1;
  int ch = idx & 1, rh = (idx >> 1) & 1, bh = (idx >> 2) & 15, kv = idx >> 6;
  int b = bh >> 1, hk = bh & 1;
  GemmArgs g;
  g.A = ((u16*)(p.ws + OFF_KVC)) + ((size_t)(b * SEQ + 16 * rh * 128)) * 256 + kv * 128 + hk * 64; g.a_rs = 16 * 256; g.a_ks = 256;
  g.B = (kv ? ((u16*)(p.ws + OFF_w1T1)) : ((u16*)(p.ws + OFF_w1T0))) + (size_t)ch * 128 * 2048; g.b_rs = 2048; g.nk = 32;
  f32x16 acc[2][2];
  gemm_main(g, smem, acc);
  int l31 = lane & 31, lh = lane >> 5;
  const float* b1 = ((float*)(p.ws + OFF_B1S)) + kv * 256 + ch * 128 + wn * 64;
  float bb0 = 0.f, bb1 = 0.f;
#pragma unroll
  for (int kq = 0; kq < 8; kq++) { bb0 += b1[kq * 512 + l31]; bb1 += b1[kq * 512 + 32 + l31]; }
#pragma unroll
  for (int mt = 0; mt < 2; mt++)
#pragma unroll
    for (int e = 0; e < 16; e++) {
      acc[mt][0][e] = gelu_tanh(acc[mt][0][e] + bb0);
      acc[mt][1][e] = gelu_tanh(acc[mt][1][e] + bb1);
    }
  stage_c(smem, acc, wm, wn, lane);
  __syncthreads();
  const u16* C = (const u16*)smem;
  const u16* w2 = (kv ? ((u16*)(p.ws + OFF_w2T1)) : ((u16*)(p.ws + OFF_w2T0))) + ch * 128;
  f32x16 o2[2];
#pragma unroll
  for (int nt = 0; nt < 2; nt++)
#pragma unroll
    for (int e = 0; e < 16; e++) o2[nt][e] = 0.f;
#pragma unroll
  for (int ks = 0; ks < 8; ks++) {
    bf16x8 a = *(const bf16x8*)(C + (wave * 32 + l31) * CLD + ks * 16 + lh * 8);
#pragma unroll
    for (int nt = 0; nt < 2; nt++) {
      bf16x8 bw = *(const bf16x8*)(w2 + (size_t)(nt * 32 + l31) * 256 + ks * 16 + lh * 8);
      o2[nt] = __builtin_amdgcn_mfma_f32_32x32x16_bf16(a, bw, o2[nt], 0, 0, 0);
    }
  }
  float* dst = ((float*)(p.ws + OFF_CACC)) + (size_t)kv * 262144 + ((size_t)bh * 256 + rh * 128 + wave * 32) * 64;
#pragma unroll
  for (int nt = 0; nt < 2; nt++)
#pragma unroll
    for (int e = 0; e < 16; e++) atomicAdd(dst + CROW(e, lh) * 64 + nt * 32 + l31, o2[nt][e]);
  __syncthreads();
}

struct LruIn { u32x4 x[2][4]; };
struct LruW { f32x4 cw[4][2]; f32x4 cbs[2]; float gba[4], gbx[4], sp[4]; bf16x8 wfa[2][4], wfx[2][4]; };
__device__ __forceinline__ void lru_load_w(const Params& p, int n, LruW& W) {
  int tid = otid(), lane = tid & 63;
  int ch8 = tid & 7, l15 = lane & 15, lq = lane >> 4;
  {
    const u16* wa = ((u16*)(p.ws + OFF_waT)) + n * 4096;
    const u16* wx = ((u16*)(p.ws + OFF_wxT)) + n * 4096;
#pragma unroll
    for (int ks = 0; ks < 2; ks++)
#pragma unroll
      for (int nt = 0; nt < 4; nt++) {
        W.wfa[ks][nt] = *(const bf16x8*)(wa + (nt * 16 + l15) * 64 + ks * 32 + lq * 8);
        W.wfx[ks][nt] = *(const bf16x8*)(wx + (nt * 16 + l15) * 64 + ks * 32 + lq * 8);
      }
  }
#pragma unroll
  for (int j = 0; j < 4; j++) {
    W.cw[j][0] = *(const f32x4*)(p.conv_w + j * 512 + n * 64 + ch8 * 8);
    W.cw[j][1] = *(const f32x4*)(p.conv_w + j * 512 + n * 64 + ch8 * 8 + 4);
  }
  W.cbs[0] = *(const f32x4*)(p.conv_b + n * 64 + ch8 * 8);
  W.cbs[1] = *(const f32x4*)(p.conv_b + n * 64 + ch8 * 8 + 4);
#pragma unroll
  for (int nt = 0; nt < 4; nt++) {
    int chn = n * 64 + nt * 16 + l15;
    W.gba[nt] = p.b_rg_a[chn]; W.gbx[nt] = p.b_rg_x[chn];
    float ee = __expf(-p.lam[chn]);
    W.sp[nt] = (ee < 0.0625f) ? ee * (1.f + ee * (-0.5f + ee * (0.33333334f + ee * (-0.25f + ee * 0.2f)))) : __logf(1.f + ee);
  }
}
__device__ __forceinline__ void lru_load(const Params& p, int idx, LruIn& L) {
  int tid = otid();
  int n = idx & 7, c = (idx >> 3) & 63, b = idx >> 9;
  int t0 = c * 64, ch8 = tid & 7, tr = tid >> 3;
#pragma unroll
  for (int ps = 0; ps < 2; ps++)
#pragma unroll
    for (int j = 0; j < 4; j++) {
      int ts = t0 + tr + ps * 32 - 3 + j;
      int tsc = ts < 0 ? 0 : ts;
      L.x[ps][j] = *(const u32x4*)(((u16*)(p.ws + OFF_XZ)) + ((size_t)(b * SEQ + tsc)) * 1024 + n * 64 + ch8 * 8);
    }
  __builtin_amdgcn_sched_barrier(0);
}
__device__ __forceinline__ void lru_local_tile(const Params& p, int idx, char* smem, const LruIn& Lin, const LruW& W) {
  int tid = otid(), lane = tid & 63, wave = tid >> 6;
  int n = idx & 7, c = (idx >> 3) & 63, b = idx >> 9;
  float* xcf = (float*)smem;
  char* xcb = smem + 16384;
  float* a_s = (float*)(smem + 24576);
  float* u_s = (float*)(smem + 40960);
  float* endA = (float*)(smem + 57344);
  float* endH = endA + 256;
  int t0 = c * 64;
  int l15 = lane & 15, lq = lane >> 4;
  int ch8 = tid & 7, tr = tid >> 3;
  u32x4 xin[2][4];
#pragma unroll
  for (int ps = 0; ps < 2; ps++)
#pragma unroll
    for (int j = 0; j < 4; j++) {
      int ts = t0 + tr + ps * 32 - 3 + j;
      xin[ps][j] = (ts < 0) ? (u32x4){0u, 0u, 0u, 0u} : Lin.x[ps][j];
    }
  __builtin_amdgcn_sched_barrier(0);
#pragma unroll
  for (int ps = 0; ps < 2; ps++) {
    int tl = tr + ps * 32;
    float y[8];
    y[0] = W.cbs[0].x; y[1] = W.cbs[0].y; y[2] = W.cbs[0].z; y[3] = W.cbs[0].w; y[4] = W.cbs[1].x; y[5] = W.cbs[1].y; y[6] = W.cbs[1].z; y[7] = W.cbs[1].w;
#pragma unroll
    for (int j = 0; j < 4; j++) {
      float f[8]; unpack8(xin[ps][j], f);
      y[0] += W.cw[j][0].x * f[0]; y[1] += W.cw[j][0].y * f[1]; y[2] += W.cw[j][0].z * f[2]; y[3] += W.cw[j][0].w * f[3];
      y[4] += W.cw[j][1].x * f[4]; y[5] += W.cw[j][1].y * f[5]; y[6] += W.cw[j][1].z * f[6]; y[7] += W.cw[j][1].w * f[7];
    }
    *(f32x4*)(xcf + tl * 64 + ch8 * 8) = (f32x4){y[0], y[1], y[2], y[3]};
    *(f32x4*)(xcf + tl * 64 + ch8 * 8 + 4) = (f32x4){y[4], y[5], y[6], y[7]};
    u32x4 o; o.x = pack2(y[0], y[1]); o.y = pack2(y[2], y[3]); o.z = pack2(y[4], y[5]); o.w = pack2(y[6], y[7]);
    *(u32x4*)(xcb + tl * 128 + ((ch8 ^ ((tl >> 1) & 7)) << 4)) = o;
  }
  __syncthreads();
  {
    f32x4 ar[4], ai[4];
#pragma unroll
    for (int nt = 0; nt < 4; nt++) { ar[nt] = (f32x4){0.f, 0.f, 0.f, 0.f}; ai[nt] = (f32x4){0.f, 0.f, 0.f, 0.f}; }
#pragma unroll
    for (int ks = 0; ks < 2; ks++) {
      int row = wave * 16 + l15, chk = ks * 4 + lq;
      bf16x8 av = *(const bf16x8*)(xcb + row * 128 + ((chk ^ ((row >> 1) & 7)) << 4));
#pragma unroll
      for (int nt = 0; nt < 4; nt++) {
        ar[nt] = __builtin_amdgcn_mfma_f32_16x16x32_bf16(av, W.wfa[ks][nt], ar[nt], 0, 0, 0);
        ai[nt] = __builtin_amdgcn_mfma_f32_16x16x32_bf16(av, W.wfx[ks][nt], ai[nt], 0, 0, 0);
      }
    }
#pragma unroll
    for (int nt = 0; nt < 4; nt++) {
      int j = nt * 16 + l15;
      float sp = W.sp[nt];
#pragma unroll
      for (int r = 0; r < 4; r++) {
        int tl = wave * 16 + lq * 4 + r;
        float rg = sigmoidf(ar[nt][r] + W.gba[nt]);
        float ig = sigmoidf(ai[nt][r] + W.gbx[nt]);
        float la = -8.f * rg * sp;
        float av = __expf(la);
        float x2 = 2.f * la;
        float om_s = -x2 * (1.f + x2 * (0.5f + x2 * (0.16666667f + x2 * (0.041666668f + x2 * 0.0083333338f))));
        float om_b = fmaf(-av, av, 1.f);
        float om = (x2 > -0.25f) ? om_s : om_b;
        float mult = __builtin_amdgcn_sqrtf(fmaxf(om, 0.f));
        float uv = mult * ig * xcf[tl * 64 + j];
        a_s[tl * 64 + j] = av;
        u_s[tl * 64 + j] = uv;
      }
    }
  }
  __syncthreads();
  int sub = tid >> 6, chl = tid & 63;
  float hs[16], cs[16];
  {
    float avv[16], uvv[16];
#pragma unroll
    for (int i = 0; i < 16; i++) { int tl = sub * 16 + i; avv[i] = a_s[tl * 64 + chl]; uvv[i] = u_s[tl * 64 + chl]; }
    __builtin_amdgcn_sched_barrier(0);
    float h = 0.f, cum = 1.f;
#pragma unroll
    for (int i = 0; i < 16; i++) { h = avv[i] * h + uvv[i]; cum *= avv[i]; hs[i] = h; cs[i] = cum; }
    endA[sub * 64 + chl] = cum; endH[sub * 64 + chl] = h;
  }
  __syncthreads();
  {
    float e0a = endA[chl], e0h = endH[chl], e1a = endA[64 + chl], e1h = endH[64 + chl], e2a = endA[128 + chl], e2h = endH[128 + chl];
    float Ain = 1.f, Hin = 0.f;
    if (sub > 0) { Hin = e0h; Ain = e0a; }
    if (sub > 1) { Hin = e1a * Hin + e1h; Ain *= e1a; }
    if (sub > 2) { Hin = e2a * Hin + e2h; Ain *= e2a; }
    float hl = 0.f, ct = 0.f;
#pragma unroll
    for (int i = 0; i < 16; i++) {
      int tl = sub * 16 + i;
      hl = hs[i] + cs[i] * Hin; ct = cs[i] * Ain;
      u_s[tl * 64 + chl] = hl; a_s[tl * 64 + chl] = ct;
    }
    if (sub == 3) {
      float* ce = ((float*)(p.ws + OFF_CE)) + ((size_t)(b * 64 + c) * 512 + n * 64 + chl) * 2;
      *(f2_t*)ce = (f2_t){ct, hl};
    }
  }
  __syncthreads();
#pragma unroll
  for (int ps = 0; ps < 2; ps++) {
    int tl = tr + ps * 32;
    size_t o = ((size_t)(b * SEQ + t0 + tl)) * 512 + n * 64 + ch8 * 8;
    f32x4 h0 = *(const f32x4*)(u_s + tl * 64 + ch8 * 8), h1 = *(const f32x4*)(u_s + tl * 64 + ch8 * 8 + 4);
    f32x4 c0 = *(const f32x4*)(a_s + tl * 64 + ch8 * 8), c1 = *(const f32x4*)(a_s + tl * 64 + ch8 * 8 + 4);
    u32x4 ho, co;
    ho.x = pack2(h0.x, h0.y); ho.y = pack2(h0.z, h0.w); ho.z = pack2(h1.x, h1.y); ho.w = pack2(h1.z, h1.w);
    co.x = pack2(c0.x, c0.y); co.y = pack2(c0.z, c0.w); co.z = pack2(c1.x, c1.y); co.w = pack2(c1.z, c1.w);
    *(u32x4*)(((u16*)(p.ws + OFF_HL)) + o) = ho;
    *(u32x4*)(((u16*)(p.ws + OFF_CA)) + o) = co;
  }
  __syncthreads();
}

__device__ __forceinline__ void phase3(const Params& p, char* smem, int tstart) {
  int blk = blockIdx.x, nb = gridDim.x;
  int first, stride, cnt;
  if (nb == 512) {
    if (blk < 128) { if (tstart == 0) compress_tile(p, blk, smem); first = blk; stride = 128; cnt = 4; }
    else { first = 512 + (blk - 128); stride = 384; cnt = (4096 - first + 383) / 384; }
  } else {
    for (int tile = tstart + blk; tile < 128; tile += nb) compress_tile(p, tile, smem);
    first = blk; stride = nb; cnt = (4096 - first + nb - 1) / nb;
    if (first >= 4096) cnt = 0;
  }
  if (cnt > 0) {
    LruIn cur, nxt;
    LruW W;
    int nW = first & 7;
    lru_load_w(p, nW, W);
    lru_load(p, first, cur);
    for (int i = 0; i < cnt; i++) {
      int t = first + i * stride;
      int tn = (i + 1 < cnt) ? t + stride : t;
      if ((t & 7) != nW) { nW = t & 7; lru_load_w(p, nW, W); }
      lru_load(p, tn, nxt);
      lru_local_tile(p, t, smem, cur, W);
      cur = nxt;
    }
  }
}

__device__ __forceinline__ void phase3b(const Params& p, char* smem) {
  int tid = otid();
  for (int tile = blockIdx.x; tile < 48; tile += gridDim.x) {
    if (tile >= 32) {
      int b = (tile - 32) >> 1, ch = ((tile - 32) & 1) * 256 + tid;
      const float* ce = ((const float*)(p.ws + OFF_CE)) + ((size_t)b * 64 * 512 + ch) * 2;
      float* cin = ((float*)(p.ws + OFF_CIN)) + (size_t)b * 64 * 512 + ch;
      float carry = 0.f;
#pragma unroll 1
      for (int c2 = 0; c2 < 2; c2++) {
        u32x2 v[32];
#pragma unroll
        for (int e = 0; e < 32; e++) v[e] = *(const u32x2*)(ce + (size_t)(c2 * 32 + e) * 1024);
        __builtin_amdgcn_sched_barrier(0);
#pragma unroll
        for (int e = 0; e < 32; e++) {
          cin[(size_t)(c2 * 32 + e) * 512] = carry;
          carry = __uint_as_float(v[e].x) * carry + __uint_as_float(v[e].y);
        }
      }
      continue;
    }
    int kv = tile >> 4, bh = tile & 15;
    const float* src = ((float*)(p.ws + OFF_CACC)) + (size_t)kv * 262144 + (size_t)bh * 256 * 64;
    if (kv == 0) {
      int ch = tid & 7;
      f32x4 ga = *(const f32x4*)(p.g_kc + ch * 8), gb = *(const f32x4*)(p.g_kc + ch * 8 + 4);
      f32x4 v0[8], v1[8];
#pragma unroll
      for (int ps = 0; ps < 8; ps++) {
        int r = (tid >> 3) + ps * 32;
        v0[ps] = *(const f32x4*)(src + r * 64 + ch * 8); v1[ps] = *(const f32x4*)(src + r * 64 + ch * 8 + 4);
      }
      __builtin_amdgcn_sched_barrier(0);
#pragma unroll
      for (int ps = 0; ps < 8; ps++) {
        int r = (tid >> 3) + ps * 32;
        f32x4 a0 = v0[ps], a1 = v1[ps];
        float ss = a0.x * a0.x + a0.y * a0.y + a0.z * a0.z + a0.w * a0.w + a1.x * a1.x + a1.y * a1.y + a1.z * a1.z + a1.w * a1.w;
        ss += dpp_xor1(ss); ss += dpp_xor2(ss); ss += __shfl_xor(ss, 4);
        float rstd = rsqrtf(ss * (1.f / 64.f) + EPSF);
        u32x4 o;
        o.x = pack2(a0.x * rstd * ga.x, a0.y * rstd * ga.y); o.y = pack2(a0.z * rstd * ga.z, a0.w * rstd * ga.w);
        o.z = pack2(a1.x * rstd * gb.x, a1.y * rstd * gb.y); o.w = pack2(a1.z * rstd * gb.z, a1.w * rstd * gb.w);
        *(u32x4*)(((u16*)(p.ws + OFF_KCN)) + ((size_t)bh * 256 + r) * 64 + ch * 8) = o;
      }
    } else {
      int d = tid >> 2, iq = tid & 3;
      u16* dst = ((u16*)(p.ws + OFF_VCT)) + ((size_t)bh * 64 + d) * 256 + iq * 64;
      float f[64];
#pragma unroll
      for (int pp = 0; pp < 64; pp++) {
        int i = iq * 64 + (pp >> 5) * 32 + ((pp >> 2) & 1) * 16 + ((pp >> 3) & 3) * 4 + (pp & 3);
        int ic = i < 255 ? i : 254;
        f[pp] = src[ic * 64 + d];
        if (i >= 255) f[pp] = 0.f;
      }
      __builtin_amdgcn_sched_barrier(0);
#pragma unroll
      for (int c8 = 0; c8 < 8; c8++) {
        u32x4 o; o.x = pack2(f[c8 * 8 + 0], f[c8 * 8 + 1]); o.y = pack2(f[c8 * 8 + 2], f[c8 * 8 + 3]); o.z = pack2(f[c8 * 8 + 4], f[c8 * 8 + 5]); o.w = pack2(f[c8 * 8 + 6], f[c8 * 8 + 7]);
        *(u32x4*)(dst + c8 * 8) = o;
      }
    }
  }
}

#define SOFF 16.f
template <int MODE>
__device__ __forceinline__ void flash_tile(const char* Kl, const char* Vl, const bf16x8 (&qf)[2], f32x4 (&O)[4], float& l,
                                           int j, int t, int t0, float slope2, bool rowsel, int lane, f32x4 (&sout)[4]) {
  int l15 = lane & 15, lq = lane >> 4;
  float cl, step;
  if (MODE == 2) { cl = slope2 * (float)(16 * (j * 64 + lq * 4) + 31 - t) - SOFF; step = slope2 * 16.f; }
  else { cl = slope2 * (float)(j * 64 + lq * 4 - t) - SOFF; step = slope2; }
  if (MODE == 0 && !rowsel) cl = -1e30f;
  f32x4 s[4];
  int sw = (l15 >> 1) & 7;
#pragma unroll
  for (int mt = 0; mt < 4; mt++)
#pragma unroll
    for (int r = 0; r < 4; r++) s[mt][r] = cl + step * (float)(mt * 16 + r);
  bf16x8 va[2][4];
  {
    bf16x8 ka[2][4];
#pragma unroll
    for (int ks = 0; ks < 2; ks++)
#pragma unroll
      for (int mt = 0; mt < 4; mt++) ka[ks][mt] = *(const bf16x8*)(Kl + (mt * 16 + l15) * 128 + (((ks * 4 + lq) ^ sw) << 4));
    __builtin_amdgcn_sched_barrier(0);
#pragma unroll
    for (int ks = 0; ks < 2; ks++)
#pragma unroll
      for (int mt = 0; mt < 4; mt++) s[mt] = __builtin_amdgcn_mfma_f32_16x16x32_bf16(ka[ks][mt], qf[ks], s[mt], 0, 0, 0);
#pragma unroll
    for (int kk = 0; kk < 2; kk++)
#pragma unroll
      for (int mt = 0; mt < 4; mt++) va[kk][mt] = *(const bf16x8*)(Vl + (mt * 16 + l15) * 128 + (((kk * 4 + lq) ^ sw) << 4));
    __builtin_amdgcn_sched_barrier(0);
  }
  bool need;
  if (MODE == 0) need = (j == (t0 >> 6));
  else if (MODE == 1) need = (j == (t0 >> 6)) || (j * 64 <= t0 - 497);
  else need = ((j * 64 + 63) * 16 + 31 > t0) || (j == 3);
  if (need) {
    { float t0v = s[0][0]; asm volatile("" : "+v"(t0v)); s[0][0] = t0v; }
#pragma unroll
    for (int mt = 0; mt < 4; mt++)
#pragma unroll
      for (int r = 0; r < 4; r++) {
        int kidx = j * 64 + mt * 16 + lq * 4 + r;
        bool valid;
        if (MODE == 0) valid = (t - kidx) >= 0;
        else if (MODE == 1) { int d = t - kidx; valid = d >= 0 && d < 512; }
        else valid = (t - (16 * kidx + 31)) >= 0 && kidx < 255;
        s[mt][r] = valid ? s[mt][r] : -1e30f;
      }
  }
  if (MODE == 2) {
#pragma unroll
    for (int mt = 0; mt < 4; mt++) sout[mt] = s[mt];
  }
  f32x4 ps = {0.f, 0.f, 0.f, 0.f};
#pragma unroll
  for (int mt = 0; mt < 4; mt++) {
#pragma unroll
    for (int r = 0; r < 4; r++) s[mt][r] = __builtin_amdgcn_exp2f(s[mt][r]);
    ps += s[mt];
  }
  l += (ps[0] + ps[1]) + (ps[2] + ps[3]);
#pragma unroll
  for (int kk = 0; kk < 2; kk++) {
    union { bf16x8 v; unsigned u[4]; } pb;
    pb.u[0] = pack2(s[2 * kk][0], s[2 * kk][1]); pb.u[1] = pack2(s[2 * kk][2], s[2 * kk][3]);
    pb.u[2] = pack2(s[2 * kk + 1][0], s[2 * kk + 1][1]); pb.u[3] = pack2(s[2 * kk + 1][2], s[2 * kk + 1][3]);
#pragma unroll
    for (int mt = 0; mt < 4; mt++) O[mt] = __builtin_amdgcn_mfma_f32_16x16x32_bf16(va[kk][mt], pb.v, O[mt], 0, 0, 0);
  }
}

struct TileRegs { u32x4 k0, k1, v0, v1; };
__device__ __forceinline__ void issue_tile(const u16* Kb, const u16* Vb, int vstride, int j, int tid, TileRegs& R) {
  int r = tid >> 3, ch = tid & 7;
  R.k0 = *(const u32x4*)(Kb + ((size_t)(j * 64 + r)) * 64 + ch * 8);
  R.k1 = *(const u32x4*)(Kb + ((size_t)(j * 64 + r + 32)) * 64 + ch * 8);
  R.v0 = *(const u32x4*)(Vb + (size_t)r * vstride + j * 64 + ch * 8);
  R.v1 = *(const u32x4*)(Vb + (size_t)(r + 32) * vstride + j * 64 + ch * 8);
  __builtin_amdgcn_sched_barrier(0);
}
#define TBUF 16384
__device__ __forceinline__ void write_tile(char* L, int tid, const TileRegs& R) {
  int r = tid >> 3, ch = tid & 7;
  int ko = r * 128 + ((ch ^ ((r >> 1) & 7)) << 4);
  *(u32x4*)(L + ko) = R.k0;
  *(u32x4*)(L + ko + 4096) = R.k1;
  *(u32x4*)(L + 8192 + ko) = R.v0;
  *(u32x4*)(L + 8192 + ko + 4096) = R.v1;
}
__device__ __forceinline__ int pop_bit(u64& um) {
  if (!um) return -1;
  int j = __builtin_ctzll(um);
  um &= um - 1;
  return j;
}

template <int MODE>
__device__ __forceinline__ void flash_branch(u64 um, const u16* Kb, const u16* Vb, int vstride, u64 mymask, const bf16x8 (&qf)[2],
                                             f32x4 (&O)[4], float& l, int t, int t0, float slope, char* L) {
  int tid = otid(), lane = tid & 63;
  TileRegs A, B;
  f32x4 dummy[4];
  um = ((u64)(unsigned)__builtin_amdgcn_readfirstlane((int)(unsigned)(um >> 32)) << 32) | (u64)(unsigned)__builtin_amdgcn_readfirstlane((int)(unsigned)um);
  int j0 = pop_bit(um), j1 = pop_bit(um), j2 = pop_bit(um);
  if (j0 < 0) return;
  const int jd = j0;
  issue_tile(Kb, Vb, vstride, j0, tid, A);
  issue_tile(Kb, Vb, vstride, j1 >= 0 ? j1 : jd, tid, B);
  __syncthreads();
  write_tile(L, tid, A);
  issue_tile(Kb, Vb, vstride, j2 >= 0 ? j2 : jd, tid, A);
  __syncthreads();
  while (true) {
    int j3 = pop_bit(um);
    write_tile(L + TBUF, tid, B);
    issue_tile(Kb, Vb, vstride, j3 >= 0 ? j3 : jd, tid, B);
    {
      bool rowsel = (MODE == 0) ? (((mymask >> j0) & 1ull) != 0) : true;
      if (__any(rowsel)) flash_tile<MODE>(L, L + 8192, qf, O, l, j0, t, t0, slope, rowsel, lane, dummy);
    }
    __syncthreads();
    if (j1 < 0) break;
    int j4 = pop_bit(um);
    write_tile(L, tid, A);
    issue_tile(Kb, Vb, vstride, j4 >= 0 ? j4 : jd, tid, A);
    {
      bool rowsel = (MODE == 0) ? (((mymask >> j1) & 1ull) != 0) : true;
      if (__any(rowsel)) flash_tile<MODE>(L + TBUF, L + TBUF + 8192, qf, O, l, j1, t, t0, slope, rowsel, lane, dummy);
    }
    __syncthreads();
    if (j2 < 0) break;
    j0 = j2; j1 = j3; j2 = j4;
  }
}

__device__ __forceinline__ void attn_hk(const Params& p, int idx, char* smem, const int hk, f32x4 (&OTh)[4]) {
  int tid = otid(), lane = tid & 63, wave = tid >> 6;
  int l15 = lane & 15, lq = lane >> 4;
  int b = idx >> 8, tq = 255 - (idx & 255);
  int t0 = tq * 16;
  int tl = wave * 4 + (l15 >> 2), gq = l15 & 3;
  int t = t0 + tl;
  int tok = b * SEQ + t;
  int cur = t0 >> 6;
  char* L = smem;
  float* imp = (float*)(smem + 32768);
  u64* selm = (u64*)(smem + 36864);
  int h = hk * 4 + gq;
  float slope = exp2f(-(float)(h + 1)) * 1.4426950408889634f;
  bf16x8 qf[2];
  qf[0] = *(const bf16x8*)(((u16*)(p.ws + OFF_Q)) + (size_t)tok * 512 + h * 64 + lq * 8);
  qf[1] = *(const bf16x8*)(((u16*)(p.ws + OFF_Q)) + (size_t)tok * 512 + h * 64 + 32 + lq * 8);
  const float* gsp = ((float*)(p.ws + OFF_GS)) + (size_t)tok * 24 + h;
  float g0 = gsp[0], g1 = gsp[8], g2 = gsp[16];
  int bh = b * 2 + hk;
  f32x4 Oacc[4];
#pragma unroll
  for (int mt = 0; mt < 4; mt++) Oacc[mt] = (f32x4){0.f, 0.f, 0.f, 0.f};
  int ntc = 0;
  if (t0 + 15 >= 31) ntc = (((t0 + 15 - 31) >> 4) >> 6) + 1;
  f32x4 sc[4][4];
#pragma unroll
  for (int kt = 0; kt < 4; kt++)
#pragma unroll
    for (int mt = 0; mt < 4; mt++) sc[kt][mt] = (f32x4){-1e30f, -1e30f, -1e30f, -1e30f};
  float lc = 0.f;
  if (ntc > 0) {
    const u16* Kb = ((u16*)(p.ws + OFF_KCN)) + (size_t)bh * 256 * 64;
    const u16* Vb = ((u16*)(p.ws + OFF_VCT)) + (size_t)bh * 64 * 256;
    TileRegs A, B;
    issue_tile(Kb, Vb, 256, 0, tid, A);
    issue_tile(Kb, Vb, 256, 1, tid, B);
    __syncthreads();
    write_tile(L, tid, A);
    issue_tile(Kb, Vb, 256, 2, tid, A);
    __syncthreads();
    write_tile(L + TBUF, tid, B);
    issue_tile(Kb, Vb, 256, 3, tid, B);
    flash_tile<2>(L, L + 8192, qf, Oacc, lc, 0, t, t0, slope, true, lane, sc[0]);
    __syncthreads();
    if (ntc > 1) {
      write_tile(L, tid, A);
      flash_tile<2>(L + TBUF, L + TBUF + 8192, qf, Oacc, lc, 1, t, t0, slope, true, lane, sc[1]);
      __syncthreads();
    }
    if (ntc > 2) {
      write_tile(L + TBUF, tid, B);
      flash_tile<2>(L, L + 8192, qf, Oacc, lc, 2, t, t0, slope, true, lane, sc[2]);
      __syncthreads();
    }
    if (ntc > 3) {
      flash_tile<2>(L + TBUF, L + TBUF + 8192, qf, Oacc, lc, 3, t, t0, slope, true, lane, sc[3]);
      __syncthreads();
    }
  }
  lc += __shfl_xor(lc, 16);
  lc += __shfl_xor(lc, 32);
  float linv = lc > 0.f ? 1.f / lc : 0.f;
  {
    float sc0 = g0 * linv;
#pragma unroll
    for (int mt = 0; mt < 4; mt++) { OTh[mt][0] = sc0 * Oacc[mt][0]; OTh[mt][1] = sc0 * Oacc[mt][1]; OTh[mt][2] = sc0 * Oacc[mt][2]; OTh[mt][3] = sc0 * Oacc[mt][3]; }
  }
  if (cur >= 16) {
    int srcl = (lane + 48) & 63;
    float p3prev = 0.f;
    int Tmax = cur >> 2;
#pragma unroll
    for (int T = 0; T < 16; T++) {
      if (T <= Tmax) {
      int kt = T >> 2, mt = T & 3;
      float p0 = __builtin_amdgcn_exp2f(sc[kt][mt][0]) * linv;
      float p1 = __builtin_amdgcn_exp2f(sc[kt][mt][1]) * linv;
      float p2 = __builtin_amdgcn_exp2f(sc[kt][mt][2]) * linv;
      float p3 = __builtin_amdgcn_exp2f(sc[kt][mt][3]) * linv;
      float Av = 2.f * (p0 + p1 + p2) + p3;
      float B3 = p3;
      Av += dpp_xor1(Av); Av += dpp_xor2(Av);
      B3 += dpp_xor1(B3); B3 += dpp_xor2(B3);
      float s1 = __shfl(B3, srcl);
      float prev = lq > 0 ? s1 : p3prev;
      p3prev = s1;
      if (gq == 0) {
        int jb = T * 4 + lq;
        unsigned key = (__float_as_uint(Av + prev) & ~63u) | (unsigned)(63 - jb);
        ((unsigned*)imp)[tl * 64 + jb] = (jb >= 1 && jb <= cur - 2) ? key : 0u;
      }
      }
    }
  }
  __syncthreads();
  {
    int nforced = cur == 0 ? 1 : (cur == 1 ? 2 : 3);
    int kk = 16 - nforced;
#pragma unroll 1
    for (int t4 = 0; t4 < 4; t4++) {
      int tt = wave * 4 + t4;
      int jb = lane;
      bool cand = (jb >= 1) && (jb <= cur - 2);
      bool forced = (jb == 0) || (jb == cur) || (jb == cur - 1);
      int rank = 0;
      if (cur >= 16) {
        const unsigned* kp = ((const unsigned*)imp) + tt * 64;
        unsigned myk = kp[jb];
        int n4 = ((cur - 2) >> 2) + 1;
#pragma unroll 4
        for (int i4 = 0; i4 < n4; i4++) {
          u32x4 kv = *(const u32x4*)(kp + i4 * 4);
          rank += (kv.x > myk) ? 1 : 0; rank += (kv.y > myk) ? 1 : 0; rank += (kv.z > myk) ? 1 : 0; rank += (kv.w > myk) ? 1 : 0;
        }
      }
      bool sel = forced || (cand && rank < kk);
      u64 mk = __ballot(sel);
      if (lane == 0) selm[tt] = mk;
    }
  }
  __syncthreads();
  {
    u64 mymask = selm[tl];
    u64 um = 0;
#pragma unroll
    for (int i = 0; i < 16; i++) um |= selm[i];
    um &= (cur >= 63) ? ~0ull : ((1ull << (cur + 1)) - 1ull);
    float l = 0.f;
#pragma unroll
    for (int mt = 0; mt < 4; mt++) Oacc[mt] = (f32x4){0.f, 0.f, 0.f, 0.f};
    flash_branch<0>(um, ((u16*)(p.ws + OFF_KS)) + (size_t)bh * SEQ * 64, ((u16*)(p.ws + OFF_VST)) + (size_t)bh * 64 * SEQ, SEQ, mymask, qf, Oacc, l, t, t0, slope, L);
    l += __shfl_xor(l, 16); l += __shfl_xor(l, 32);
    float sc1 = l > 0.f ? g1 / l : 0.f;
#pragma unroll
    for (int mt = 0; mt < 4; mt++) { OTh[mt][0] += sc1 * Oacc[mt][0]; OTh[mt][1] += sc1 * Oacc[mt][1]; OTh[mt][2] += sc1 * Oacc[mt][2]; OTh[mt][3] += sc1 * Oacc[mt][3]; }
  }
  {
    int lo = t0 - 511;
    int jlo = lo > 0 ? (lo >> 6) : 0;
    u64 wm_ = ((cur >= 63) ? ~0ull : ((1ull << (cur + 1)) - 1ull)) & ~((1ull << jlo) - 1ull);
    float l = 0.f;
#pragma unroll
    for (int mt = 0; mt < 4; mt++) Oacc[mt] = (f32x4){0.f, 0.f, 0.f, 0.f};
    flash_branch<1>(wm_, ((u16*)(p.ws + OFF_KW)) + (size_t)bh * SEQ * 64, ((u16*)(p.ws + OFF_VWT)) + (size_t)bh * 64 * SEQ, SEQ, 0ull, qf, Oacc, l, t, t0, slope, L);
    l += __shfl_xor(l, 16); l += __shfl_xor(l, 32);
    float sc2 = l > 0.f ? g2 / l : 0.f;
#pragma unroll
    for (int mt = 0; mt < 4; mt++) { OTh[mt][0] += sc2 * Oacc[mt][0]; OTh[mt][1] += sc2 * Oacc[mt][1]; OTh[mt][2] += sc2 * Oacc[mt][2]; OTh[mt][3] += sc2 * Oacc[mt][3]; }
  }
}

__device__ __forceinline__ void attn_tile(const Params& p, int idx, char* smem) {
  int tid = otid(), lane = tid & 63, wave = tid >> 6;
  int l15 = lane & 15, lq = lane >> 4;
  int b = idx >> 8, tq = 255 - (idx & 255);
  int t0 = tq * 16;
  int tl = wave * 4 + (l15 >> 2), gq = l15 & 3;
  int t = t0 + tl;
  int tok = b * SEQ + t;
  int cur = t0 >> 6;
  char* Kl = smem;
  char* Vl = smem + 8192;
  float* imp = (float*)(smem + 17408);
  u64* selm = (u64*)(smem + 21504);
  u32x2 zpre[2][4];
#pragma unroll
  for (int hk = 0; hk < 2; hk++)
#pragma unroll
    for (int mt = 0; mt < 4; mt++)
      zpre[hk][mt] = __builtin_nontemporal_load((const u32x2*)(((u16*)(p.ws + OFF_ZN)) + (size_t)tok * 512 + (hk * 4 + gq) * 64 + mt * 16 + lq * 4));
  f32x4 OT0[4], OT1[4];
  f32x4* park = (f32x4*)(smem + 40960);
#pragma unroll 1
  for (int hk = 0; hk < 2; hk++) {
    attn_hk(p, idx, smem, hk, OT1);
    if (hk == 0) {
#pragma unroll
      for (int mt = 0; mt < 4; mt++) park[mt * 256 + tid] = OT1[mt];
    }
  }
#pragma unroll
  for (int mt = 0; mt < 4; mt++) OT0[mt] = park[mt * 256 + tid];
  float ss = 0.f;
#pragma unroll
  for (int mt = 0; mt < 4; mt++)
#pragma unroll
    for (int r = 0; r < 4; r++) ss += OT0[mt][r] * OT0[mt][r] + OT1[mt][r] * OT1[mt][r];
  ss += dpp_xor1(ss); ss += dpp_xor2(ss); ss += __shfl_xor(ss, 16); ss += __shfl_xor(ss, 32);
  float rstd = rsqrtf(ss * (1.f / 512.f) + EPSF);
#pragma unroll
  for (int hk = 0; hk < 2; hk++)
#pragma unroll
    for (int mt = 0; mt < 4; mt++) {
      f32x4 ov = hk ? OT1[mt] : OT0[mt];
      int col = (hk * 4 + gq) * 64 + mt * 16 + lq * 4;
      f32x4 gg = *(const f32x4*)(p.g_on + col);
      u32x2 zz = zpre[hk][mt];
      float z0 = __uint_as_float(zz.x << 16), z1 = __uint_as_float(zz.x & 0xffff0000u);
      float z2 = __uint_as_float(zz.y << 16), z3 = __uint_as_float(zz.y & 0xffff0000u);
      u32x2 o;
      o.x = pack2(ov[0] * rstd * gg.x * siluf(z0), ov[1] * rstd * gg.y * siluf(z1));
      o.y = pack2(ov[2] * rstd * gg.z * siluf(z2), ov[3] * rstd * gg.w * siluf(z3));
      *(u32x2*)(((u16*)(p.ws + OFF_Y)) + (size_t)tok * 1024 + 512 + col) = o;
    }
}

__device__ __forceinline__ void lru_final_tile(const Params& p, int idx, char* smem) {
  int tid = otid(), lane = tid & 63, wave = tid >> 6;
  int c = idx & 63, b = idx >> 6;
  const float* cin = ((const float*)(p.ws + OFF_CIN)) + ((size_t)(b * 64 + c)) * 512;
  float cr[8], gg[8];
#pragma unroll
  for (int e = 0; e < 8; e++) { cr[e] = cin[lane * 8 + e]; gg[e] = p.g_ol[lane * 8 + e]; }
  for (int i = 0; i < 16; i++) {
    int tok = b * SEQ + c * 64 + wave * 16 + i;
    u32x4 hv = __builtin_nontemporal_load((const u32x4*)(((u16*)(p.ws + OFF_HL)) + (size_t)tok * 512 + lane * 8));
    u32x4 cv = __builtin_nontemporal_load((const u32x4*)(((u16*)(p.ws + OFF_CA)) + (size_t)tok * 512 + lane * 8));
    u32x4 zv = __builtin_nontemporal_load((const u32x4*)(((u16*)(p.ws + OFF_XZ)) + (size_t)tok * 1024 + 512 + lane * 8));
    float hf[8], cf[8], zf[8];
    unpack8(hv, hf); unpack8(cv, cf); unpack8(zv, zf);
    float ss = 0.f;
#pragma unroll
    for (int e = 0; e < 8; e++) { hf[e] = hf[e] + cf[e] * cr[e]; ss += hf[e] * hf[e]; }
    { ss += dpp_xor1(ss); ss += dpp_xor2(ss); ss += dpp_ror4(ss); ss += dpp_ror8(ss); ss += __shfl_xor(ss, 16); ss += __shfl_xor(ss, 32); }
    float rstd = rsqrtf(ss * (1.f / 512.f) + EPSF);
    float y[8];
#pragma unroll
    for (int e = 0; e < 8; e++) y[e] = hf[e] * rstd * gg[e] * siluf(zf[e]);
    u32x4 o; o.x = pack2(y[0], y[1]); o.y = pack2(y[2], y[3]); o.z = pack2(y[4], y[5]); o.w = pack2(y[6], y[7]);
    *(u32x4*)(((u16*)(p.ws + OFF_Y)) + (size_t)tok * 1024 + lane * 8) = o;
  }
}

__device__ __forceinline__ void phase4(const Params& p, char* smem) {
  for (int tile = blockIdx.x; tile < 2048 + 512; tile += gridDim.x) {
    if (tile < 2048) attn_tile(p, ((tile & 7) << 8) | (tile >> 3), smem);
    else lru_final_tile(p, tile - 2048, smem);
  }
}

__device__ __forceinline__ void gemm_out_tile(const Params& p, int tm, int tn, char* smem) {
  int tid = otid(), lane = tid & 63, wave = tid >> 6, wm = wave >> 1, wn = wave & 1;
  GemmArgs g;
  g.A = ((u16*)(p.ws + OFF_Y)) + (size_t)tm * 128 * 1024; g.a_rs = 1024; g.a_ks = 64;
  g.B = ((u16*)(p.ws + OFF_woutT)) + (size_t)tn * 128 * 1024; g.b_rs = 1024; g.nk = 16;
  int tok0 = tm * 128, b = tok0 >> 12;
  int c4 = tid & 31, r0 = tid >> 5;
  int col = tn * 128 + c4 * 4;
  f32x4 gt = *(const f32x4*)(((float*)(p.ws + OFF_MODZ)) + b * 3072 + 2048 + col);
  f32x4 xa[8], xb[8];
#pragma unroll
  for (int ps = 0; ps < 8; ps++) xa[ps] = __builtin_nontemporal_load((const f32x4*)(p.x + (size_t)(tok0 + r0 + ps * 8) * 1024 + col));
  f32x16 acc[2][2];
  gemm_main(g, smem, acc);
  int l31 = lane & 31, lh = lane >> 5;
  float* Cf = (float*)smem;
#pragma unroll
  for (int mt = 0; mt < 2; mt++)
#pragma unroll
    for (int nt = 0; nt < 2; nt++)
#pragma unroll
      for (int e = 0; e < 16; e++)
        Cf[(wm * 64 + mt * 32 + CROW(e, lh)) * 128 + wn * 64 + nt * 32 + l31] = acc[mt][nt][e];
#pragma unroll
  for (int ps = 0; ps < 8; ps++) xb[ps] = __builtin_nontemporal_load((const f32x4*)(p.x + (size_t)(tok0 + r0 + (8 + ps) * 8) * 1024 + col));
  __syncthreads();
#pragma unroll
  for (int ps = 0; ps < 8; ps++) {
    int r = r0 + ps * 8;
    f32x4 v = *(const f32x4*)(Cf + r * 128 + c4 * 4);
    f32x4 o = xa[ps] + gt * v;
    __builtin_nontemporal_store(o, (f32x4*)(p.out + (size_t)(tok0 + r) * 1024 + col));
  }
#pragma unroll
  for (int ps = 0; ps < 8; ps++) {
    int r = r0 + (8 + ps) * 8;
    f32x4 v = *(const f32x4*)(Cf + r * 128 + c4 * 4);
    f32x4 o = xb[ps] + gt * v;
    __builtin_nontemporal_store(o, (f32x4*)(p.out + (size_t)(tok0 + r) * 1024 + col));
  }
  __syncthreads();
}
__device__ __forceinline__ void phase5(const Params& p, char* smem) {
  int xcd = blockIdx.x & 7, loc = blockIdx.x >> 3, nloc = gridDim.x >> 3;
  for (int v = loc; v < 4 * 64; v += nloc) {
    int st = (v >> 6) * 8 + xcd, w = v & 63;
    gemm_out_tile(p, st * 8 + (w >> 3), w & 7, smem);
  }
}

template <int PH>
__global__ void __launch_bounds__(256, LB_MIN) phase_kernel(Params p) {
  __shared__ __attribute__((aligned(16))) char smem[65536];
  if (PH == 0) phase0(p, smem);
  if (PH == 1) phase1(p, smem);
  if (PH == 2) phase2(p, smem);
  if (PH == 3) phase3(p, smem, 0);
  if (PH == 4) phase4(p, smem);
  if (PH == 5) phase5(p, smem);
  if (PH == 6) phase3b(p, smem);
}

#define XB_TMO      128
#define XB_XCNT(j)  (256  + 64 * (j))
#define XB_XSUB(j)  (1280 + 64 * (j))
#define XB_XGEN(j)  (2304 + 64 * (j))
#define XB_TOP      3328
#define XB_TOPGEN   3392
#define XCD_BAR_WORDS 3456
#define XB_SPIN_CAP (1u << 20)
__device__ __forceinline__ unsigned xb_ld(unsigned* p) { return __hip_atomic_load(p, __ATOMIC_RELAXED, __HIP_MEMORY_SCOPE_AGENT); }
__device__ __forceinline__ unsigned xb_add(unsigned* p, unsigned v) { return __hip_atomic_fetch_add(p, v, __ATOMIC_RELAXED, __HIP_MEMORY_SCOPE_AGENT); }
__device__ __forceinline__ unsigned xb_xcc_id() { return (unsigned)__builtin_amdgcn_s_getreg((3 << 11) | 20) & 0xFu; }
#define XB_SPIN(cond, bar) do { unsigned _sp = 0; while (cond) { __builtin_amdgcn_s_sleep(1); \
    if ((++_sp & 255u) == 0u) { if (xb_ld(&(bar)[XB_TMO])) break; if (_sp > XB_SPIN_CAP) { atomicAdd(&(bar)[XB_TMO], 1u); break; } } } } while (0)
struct XcdBarrier { unsigned* bar; unsigned x; unsigned nloc; unsigned nx; };
__device__ __forceinline__ void xcd_barrier_complete(unsigned* bar, unsigned x, unsigned& nloc, unsigned& nx) {
  const unsigned G = gridDim.x;
  unsigned sum, cnt, mine, sp = 0u;
  for (;;) {
    sum = 0u; cnt = 0u; mine = 0u;
#pragma unroll
    for (unsigned j = 0; j < 16; ++j) { const unsigned c = xb_ld(&bar[XB_XCNT(j)]); sum += c; cnt += (c > 0u) ? 1u : 0u; mine = (j == x) ? c : mine; }
    if (sum == G) break;
    __builtin_amdgcn_s_sleep(1);
    if ((++sp & 255u) == 0u) { if (xb_ld(&bar[XB_TMO])) break; if (sp > XB_SPIN_CAP) { atomicAdd(&bar[XB_TMO], 1u); break; } }
  }
  nloc = mine > 0u ? mine : 1u; nx = cnt > 0u ? cnt : 1u;
}
__device__ __forceinline__ void xcd_barrier(XcdBarrier& b) {
  asm volatile("s_waitcnt vmcnt(0)" ::: "memory");
  __syncthreads();
  if (threadIdx.x == 0) {
    unsigned* bar = b.bar;
    __builtin_amdgcn_s_waitcnt(0);
    unsigned nloc = b.nloc, nx = b.nx;
    if (nloc == 0u) { xcd_barrier_complete(bar, b.x, nloc, nx); b.nloc = nloc; b.nx = nx; }
    const unsigned old = xb_add(&bar[XB_XSUB(b.x)], 1u);
    const unsigned gen = old / nloc;
    if (old + 1u == (gen + 1u) * nloc) {
      __builtin_amdgcn_fence(__ATOMIC_RELEASE, "agent");
      asm volatile("s_waitcnt vmcnt(0)" ::: "memory");
      const unsigned og = xb_add(&bar[XB_TOP], 1u);
      const unsigned tg = og / nx;
      if (og + 1u == (tg + 1u) * nx) xb_add(&bar[XB_TOPGEN], 1u);
      else XB_SPIN(xb_ld(&bar[XB_TOPGEN]) == tg, bar);
      __builtin_amdgcn_fence(__ATOMIC_ACQUIRE, "agent");
      xb_add(&bar[XB_XGEN(b.x)], 1u);
      asm volatile("s_waitcnt vmcnt(0)" ::: "memory");
    } else {
      XB_SPIN(xb_ld(&bar[XB_XGEN(b.x)]) == gen, bar);
      __builtin_amdgcn_fence(__ATOMIC_ACQUIRE, "agent");
      asm volatile("s_waitcnt vmcnt(0)" ::: "memory");
    }
  }
  __syncthreads();
}

__global__ void __launch_bounds__(256, LB_MIN) fused_kernel(Params p) {
  __shared__ __attribute__((aligned(16))) char smem[65536];
  unsigned* bar = (unsigned*)(p.ws + OFF_BAR);
  XcdBarrier xb; xb.bar = bar; xb.x = xb_xcc_id(); xb.nloc = 0u; xb.nx = 0u;
  if (threadIdx.x == 0) (void)xb_add(&bar[XB_XCNT(xb.x)], 1u);
  phase0(p, smem); xcd_barrier(xb);
#if PROBE_PH == 1
  phase1(p, smem); xcd_barrier(xb);
#endif
  phase1(p, smem); xcd_barrier(xb);
#if PROBE_PH == 2
  phase2(p, smem); xcd_barrier(xb);
#endif
  phase2(p, smem); xcd_barrier(xb);
#if PROBE_PH == 3
  phase3(p, smem, 128); xcd_barrier(xb);
#endif
  phase3(p, smem, 0); xcd_barrier(xb);
  phase3b(p, smem); xcd_barrier(xb);
#if PROBE_PH == 4
  phase4(p, smem); xcd_barrier(xb);
#endif
  phase4(p, smem); xcd_barrier(xb);
#if PROBE_PH == 5
  phase5(p, smem); xcd_barrier(xb);
#endif
  phase5(p, smem);
}

extern "C" void kernel_launch(void* const* d_in, const int* in_sizes, int n_in, void* d_out, int out_size, void* d_ws,
                              size_t ws_size, hipStream_t stream) {
  Params p{};
  const float* const* in = (const float* const*)d_in;
  p.x = in[0]; p.c = in[1]; p.w_ada = in[2]; p.b_ada = in[3]; p.norm_g = in[4]; p.w_in = in[5]; p.conv_w = in[6]; p.conv_b = in[7];
  p.w_rg_a = in[8]; p.b_rg_a = in[9]; p.w_rg_x = in[10]; p.b_rg_x = in[11]; p.lam = in[12];
  p.pos_k = in[13]; p.w1_k = in[14]; p.w2_k = in[15]; p.pos_v = in[16]; p.w1_v = in[17]; p.w2_v = in[18];
  p.g_q = in[19]; p.g_kc = in[20]; p.g_ks = in[21]; p.g_kw = in[22]; p.g_ol = in[23]; p.g_on = in[24]; p.w_out = in[25];
  p.out = (float*)d_out;
  p.ws = (char*)d_ws;
  (void)ws_size; (void)in_sizes; (void)n_in; (void)out_size;
#if FUSED
  static int grid_blocks = 0;
  if (!grid_blocks) {
    int dev = 0, cus = 0, per_cu = 0;
    hipGetDevice(&dev);
    hipDeviceGetAttribute(&cus, hipDeviceAttributeMultiprocessorCount, dev);
    hipOccupancyMaxActiveBlocksPerMultiprocessor(&per_cu, fused_kernel, 256, 0);
    if (per_cu > 2) per_cu = 2;
    grid_blocks = cus * per_cu;
  }
  void* args[] = {&p};
  (void)hipMemsetAsync(p.ws + OFF_BAR, 0, 16384 + 8 * 3072 * 4, stream);
  hipError_t e = hipLaunchCooperativeKernel((void*)fused_kernel, dim3(grid_blocks), dim3(256), args, 0, stream);
  if (e != hipSuccess) fprintf(stderr, "cooperative launch failed: %s (grid %d)\n", hipGetErrorString(e), grid_blocks);
#else
  const int G = 1024;
  phase_kernel<0><<<G, 256, 0, stream>>>(p);
  phase_kernel<1><<<G, 256, 0, stream>>>(p);
  phase_kernel<2><<<G, 256, 0, stream>>>(p);
  phase_kernel<3><<<G, 256, 0, stream>>>(p);
  phase_kernel<6><<<G, 256, 0, stream>>>(p);
  phase_kernel<4><<<G, 256, 0, stream>>>(p);
  phase_kernel<5><<<G, 256, 0, stream>>>(p);
#endif
}
```
